# Optimizing an MI355X kernel written in HIP

```python
import jax, jax.numpy as jnp
from jax import lax
import numpy as np

D_MODEL = 1024
BATCH = 8
SEQ = 2048
DEPTH = 1

D_MIX = D_MODEL
SB_HEAD_DIM = 64
SB_WIDTH = D_MIX // 2
SB_HEADS = SB_WIDTH // SB_HEAD_DIM
GDN_HEAD_DIM = 128
GDN_WIDTH = D_MIX - SB_WIDTH
GDN_HEADS = GDN_WIDTH // GDN_HEAD_DIM
CONV_WIDTH = 4
CHUNK = 64
BLOCK_Q = 128
EPS = 1e-6
IN_SPLITS = (SB_WIDTH, SB_WIDTH, SB_WIDTH, SB_WIDTH,
             GDN_WIDTH, GDN_WIDTH, GDN_WIDTH, GDN_WIDTH,
             GDN_HEADS, GDN_HEADS)
D_IN = sum(IN_SPLITS)

kernel_name = "hybrid_stickbreak_gated_deltanet_block"


def rmsnorm(x, w):
    x32 = x.astype(jnp.float32)
    y = x32 * lax.rsqrt(jnp.mean(x32 * x32, axis=-1, keepdims=True) + EPS)
    return (y * w.astype(jnp.float32)).astype(x.dtype)


def l2norm(x):
    x32 = x.astype(jnp.float32)
    return x32 * lax.rsqrt(jnp.sum(x32 * x32, axis=-1, keepdims=True) + EPS)


def causal_depthwise_conv(x, w):
    k_taps, t_len = w.shape[0], x.shape[1]
    xp = jnp.pad(x, ((0, 0), (k_taps - 1, 0), (0, 0)))
    out = xp[:, 0:t_len] * w[0]
    for i in range(1, k_taps):
        out = out + xp[:, i:i + t_len] * w[i]
    return out


def stick_breaking_attention(q, k, v):
    t_len, d = q.shape[2], q.shape[3]
    scale = float(1.0 / np.sqrt(d))
    outs = []
    for blk in range(t_len // BLOCK_Q):
        start, end = blk * BLOCK_Q, (blk + 1) * BLOCK_Q
        qb = q[:, :, start:end]
        kb, vb = k[:, :, :end], v[:, :, :end]
        z = jnp.einsum('bhqd,bhkd->bhqk', qb, kb).astype(jnp.float32) * scale
        t_idx = start + jnp.arange(BLOCK_Q)
        s_idx = jnp.arange(end)
        causal = s_idx[None, :] < t_idx[:, None]
        sp = jnp.where(causal, jax.nn.softplus(z), 0.0)
        tail = lax.cumsum(sp, axis=sp.ndim - 1, reverse=True) - sp
        attn = jnp.where(causal, jnp.exp(jax.nn.log_sigmoid(z) - tail), 0.0)
        outs.append(jnp.einsum('bhqk,bhkd->bhqd', attn.astype(v.dtype), vb))
    return jnp.concatenate(outs, axis=2)


def gated_delta_chunked(q, k, v, g, beta):
    out_dtype = v.dtype
    b, h, t_len, dk = q.shape
    dv = v.shape[-1]
    n_chunks = t_len // CHUNK
    q = q.astype(jnp.float32) * float(dk ** -0.5)
    k = k.astype(jnp.float32)
    v = v.astype(jnp.float32)
    resh = lambda a: a.reshape((b, h, n_chunks, CHUNK) + a.shape[3:])
    q, k, v, g, beta = resh(q), resh(k), resh(v), resh(g.astype(jnp.float32)), resh(beta.astype(jnp.float32))
    g = lax.cumsum(g, axis=g.ndim - 1)
    incl = jnp.tril(jnp.ones((CHUNK, CHUNK), dtype=bool))
    strict = jnp.tril(jnp.ones((CHUNK, CHUNK), dtype=bool), k=-1)
    decay = jnp.exp(jnp.where(incl, g[..., :, None] - g[..., None, :], -jnp.inf))
    k_beta = k * beta[..., None]
    v_beta = v * beta[..., None]
    a_mat = jnp.where(strict, jnp.einsum('bhnid,bhnjd->bhnij', k_beta, k) * decay, 0.0)
    eye = jnp.eye(CHUNK, dtype=jnp.float32)
    rhs = jnp.concatenate([v_beta, k_beta * jnp.exp(g)[..., None]], axis=-1)
    sol = lax.linalg.triangular_solve(a_mat + eye, rhs, left_side=True, lower=True,
                                      unit_diagonal=True)
    u, w = sol[..., :dv], sol[..., dv:]
    attn_intra = jnp.where(incl, jnp.einsum('bhnid,bhnjd->bhnij', q, k) * decay, 0.0)

    def step(state, inp):
        q_c, k_c, u_c, w_c, g_c, a_c = inp
        v_new = u_c - jnp.einsum('bhcd,bhde->bhce', w_c, state)
        o_c = jnp.einsum('bhcd,bhde->bhce', q_c * jnp.exp(g_c)[..., None], state) \
            + jnp.einsum('bhij,bhje->bhie', a_c, v_new)
        g_last = g_c[..., -1]
        state = state * jnp.exp(g_last)[..., None, None] + jnp.einsum(
            'bhcd,bhce->bhde', k_c * jnp.exp(g_last[..., None] - g_c)[..., None], v_new)
        return state, o_c

    mv = lambda a: jnp.moveaxis(a, 2, 0)
    state0 = jnp.zeros((b, h, dk, dv), dtype=jnp.float32)
    _, o = lax.scan(step, state0, (mv(q), mv(k), mv(u), mv(w), mv(g), mv(attn_intra)))
    o = jnp.moveaxis(o, 0, 2).reshape(b, h, t_len, dv)
    return o.astype(out_dtype)


def setup_inputs(seed: int = 0) -> dict:
    key = jax.random.key(seed)
    ks = jax.random.split(key, 10)
    f32 = jnp.float32
    x = jax.random.normal(ks[0], (BATCH, SEQ, D_MODEL), f32)
    norm1_w = 1.0 + 0.02 * jax.random.normal(ks[1], (DEPTH, D_MODEL), f32)
    w_in = jax.random.normal(ks[2], (DEPTH, D_MODEL, D_IN), f32) * D_MODEL ** -0.5
    sb_norm_w = 1.0 + 0.02 * jax.random.normal(ks[3], (DEPTH, SB_HEAD_DIM), f32)
    gdn_conv_w = jax.random.normal(ks[4], (DEPTH, CONV_WIDTH, 3 * GDN_WIDTH), f32) * CONV_WIDTH ** -0.5
    gdn_A_log = jnp.log(jax.random.uniform(ks[5], (DEPTH, GDN_HEADS), f32, 1.0, 16.0))
    dt = jnp.exp(jax.random.uniform(ks[6], (DEPTH, GDN_HEADS), f32, float(np.log(1e-3)), float(np.log(1e-1))))
    gdn_dt_bias = dt + jnp.log(-jnp.expm1(-dt))
    gdn_norm_w = 1.0 + 0.02 * jax.random.normal(ks[7], (DEPTH, GDN_HEAD_DIM), f32)
    w_out = jax.random.normal(ks[8], (DEPTH, D_MIX, D_MODEL), f32) * D_MIX ** -0.5
    final_norm_w = 1.0 + 0.02 * jax.random.normal(ks[9], (D_MODEL,), f32)
    return {"x": x, "norm1_w": norm1_w, "w_in": w_in, "sb_norm_w": sb_norm_w,
            "gdn_conv_w": gdn_conv_w, "gdn_A_log": gdn_A_log, "gdn_dt_bias": gdn_dt_bias,
            "gdn_norm_w": gdn_norm_w, "w_out": w_out, "final_norm_w": final_norm_w}


def reference(x, norm1_w, w_in, sb_norm_w, gdn_conv_w, gdn_A_log, gdn_dt_bias,
              gdn_norm_w, w_out, final_norm_w):
    b, t_len, _ = x.shape
    split_idx = [int(s) for s in np.cumsum(IN_SPLITS)[:-1]]
    to_heads = lambda a, n, d: a.reshape(b, t_len, n, d).transpose(0, 2, 1, 3)
    for layer in range(DEPTH):
        h = rmsnorm(x, norm1_w[layer])
        proj = jnp.einsum('btd,de->bte', h, w_in[layer])
        sb_q, sb_k, sb_v, sb_z, g_q, g_k, g_v, g_z, g_b, g_a = jnp.split(proj, split_idx, axis=-1)

        o_sb = stick_breaking_attention(to_heads(sb_q, SB_HEADS, SB_HEAD_DIM),
                                        to_heads(sb_k, SB_HEADS, SB_HEAD_DIM),
                                        to_heads(sb_v, SB_HEADS, SB_HEAD_DIM))
        o_sb = rmsnorm(o_sb.transpose(0, 2, 1, 3), sb_norm_w[layer]).reshape(b, t_len, SB_WIDTH)
        o_sb = o_sb * jax.nn.silu(sb_z)

        qkv = jax.nn.silu(causal_depthwise_conv(jnp.concatenate([g_q, g_k, g_v], axis=-1),
                                                gdn_conv_w[layer]))
        gq, gk, gv = jnp.split(qkv, 3, axis=-1)
        gq = l2norm(to_heads(gq, GDN_HEADS, GDN_HEAD_DIM)).astype(x.dtype)
        gk = l2norm(to_heads(gk, GDN_HEADS, GDN_HEAD_DIM)).astype(x.dtype)
        gv = to_heads(gv, GDN_HEADS, GDN_HEAD_DIM)
        beta = jax.nn.sigmoid(g_b.astype(jnp.float32)).transpose(0, 2, 1)
        decay = (-jnp.exp(gdn_A_log[layer].astype(jnp.float32))
                 * jax.nn.softplus(g_a.astype(jnp.float32) + gdn_dt_bias[layer].astype(jnp.float32)))
        decay = decay.transpose(0, 2, 1)
        o_gdn = gated_delta_chunked(gq, gk, gv, decay, beta)
        o_gdn = rmsnorm(o_gdn.transpose(0, 2, 1, 3), gdn_norm_w[layer]).reshape(b, t_len, GDN_WIDTH)
        o_gdn = o_gdn * jax.nn.silu(g_z)

        mixed = jnp.concatenate([o_sb, o_gdn], axis=-1)
        x = x + jnp.einsum('bte,ed->btd', mixed, w_out[layer])
    return rmsnorm(x, final_norm_w)
```

```cpp
#include <hip/hip_runtime.h>
#include <hip/hip_bf16.h>
#include <hip/hip_cooperative_groups.h>
#include <cstdio>
namespace cg = cooperative_groups;

typedef unsigned short bf16_t;
using bf16x8 = __attribute__((ext_vector_type(8))) short;
using bf16x4 = __attribute__((ext_vector_type(4))) short;
using f32x16 = __attribute__((ext_vector_type(16))) float;
using f32x4 = __attribute__((ext_vector_type(4))) float;

#define NTHREADS 512
#define M_TOK 16384
#define T_SEQ 2048
#define D_MODEL 1024
#define D_IN 4104
#define NPROJ 4096
#define EPS 1e-6f
#define QSCALE 0.18033688011112042f

struct Params {
  const float* x; const float* norm1_w; const float* w_in; const float* sb_norm_w;
  const float* conv_w; const float* A_log; const float* dt_bias; const float* gdn_norm_w;
  const float* w_out; const float* final_w;
  float* out;
  bf16_t* Wt; bf16_t* WoT; float* gba; unsigned* counters; float* eglast;
  bf16_t* h; bf16_t* mixed; bf16_t* proj;
  bf16_t* U; bf16_t* W; bf16_t* QG; bf16_t* KDt; bf16_t* AI;
};

__device__ __forceinline__ bf16_t f2bf(float f) {
  unsigned u = __float_as_uint(f);
  u += 0x7fffu + ((u >> 16) & 1u);
  return (bf16_t)(u >> 16);
}
__device__ __forceinline__ float bf2f(bf16_t b) { return __uint_as_float(((unsigned)b) << 16); }
__device__ __forceinline__ float wave_sum(float v) {
#pragma unroll
  for (int o = 32; o > 0; o >>= 1) v += __shfl_xor(v, o);
  return v;
}
__device__ __forceinline__ float silu_f(float x) { return x / (1.f + __expf(-x)); }

__device__ void phase0(const Params& p, char* smem) {
  const int tid = threadIdx.x, lane = tid & 63, wid = tid >> 6;
  if (blockIdx.x == 0 && tid < 16) p.counters[tid] = 0u;
  const int gw = blockIdx.x * 8 + wid, nw = gridDim.x * 8;
  for (int row = gw; row < M_TOK; row += nw) {
    const float4* xr = (const float4*)(p.x + (size_t)row * D_MODEL);
    float4 v[4];
    float ss = 0.f;
#pragma unroll
    for (int i = 0; i < 4; i++) {
      v[i] = xr[lane + 64 * i];
      ss += v[i].x * v[i].x + v[i].y * v[i].y + v[i].z * v[i].z + v[i].w * v[i].w;
    }
    ss = wave_sum(ss);
    const float rstd = rsqrtf(ss * (1.f / D_MODEL) + EPS);
    float a0 = 0, a1 = 0, a2 = 0, a3 = 0, a4 = 0, a5 = 0, a6 = 0, a7 = 0;
#pragma unroll
    for (int i = 0; i < 4; i++) {
      const float4 w = ((const float4*)p.norm1_w)[lane + 64 * i];
      float hv[4];
      hv[0] = v[i].x * rstd * w.x; hv[1] = v[i].y * rstd * w.y;
      hv[2] = v[i].z * rstd * w.z; hv[3] = v[i].w * rstd * w.w;
      bf16x4 hb;
      hb[0] = (short)f2bf(hv[0]); hb[1] = (short)f2bf(hv[1]); hb[2] = (short)f2bf(hv[2]); hb[3] = (short)f2bf(hv[3]);
      *(bf16x4*)(p.h + (size_t)row * D_MODEL + (lane + 64 * i) * 4) = hb;
#pragma unroll
      for (int c = 0; c < 4; c++) {
        const int k = (lane + 64 * i) * 4 + c;
        const float4* wp = (const float4*)(p.w_in + (size_t)k * D_IN + NPROJ);
        const float4 wa = wp[0], wb = wp[1];
        a0 += hv[c] * wa.x; a1 += hv[c] * wa.y; a2 += hv[c] * wa.z; a3 += hv[c] * wa.w;
        a4 += hv[c] * wb.x; a5 += hv[c] * wb.y; a6 += hv[c] * wb.z; a7 += hv[c] * wb.w;
      }
    }
    a0 = wave_sum(a0); a1 = wave_sum(a1); a2 = wave_sum(a2); a3 = wave_sum(a3);
    a4 = wave_sum(a4); a5 = wave_sum(a5); a6 = wave_sum(a6); a7 = wave_sum(a7);
    if (lane == 0) {
      float4* g = (float4*)(p.gba + (size_t)row * 8);
      g[0] = make_float4(a0, a1, a2, a3);
      g[1] = make_float4(a4, a5, a6, a7);
    }
  }
  float* tile = (float*)smem;
  const int tx = tid & 63, ty = tid >> 6;
  for (int t = blockIdx.x; t < 1280; t += gridDim.x) {
    const float* src; bf16_t* dst; int ld, k0, n0;
    if (t < 1024) { src = p.w_in; ld = D_IN; k0 = (t >> 6) * 64; n0 = (t & 63) * 64; dst = p.Wt; }
    else { const int u = t - 1024; src = p.w_out; ld = 1024; k0 = (u >> 4) * 64; n0 = (u & 15) * 64; dst = p.WoT; }
#pragma unroll
    for (int r = 0; r < 8; r++) tile[(ty * 8 + r) * 65 + tx] = src[(size_t)(k0 + ty * 8 + r) * ld + n0 + tx];
    __syncthreads();
#pragma unroll
    for (int r = 0; r < 8; r++) {
      const int n = ty * 8 + r;
      dst[(size_t)(n0 + n) * 1024 + k0 + tx] = f2bf(tile[tx * 65 + n]);
    }
    __syncthreads();
  }
}

#define GLD 72
template <int EPI>
__device__ void gemm_tile(const Params& p, const bf16_t* __restrict__ A, const bf16_t* __restrict__ Bt,
                          const int K, const int m0, const int n0, char* smem) {
  bf16_t* As = (bf16_t*)smem;
  bf16_t* Bs = As + 256 * GLD;
  const int tid = threadIdx.x, lane = tid & 63, wid = tid >> 6;
  const int r = lane & 31, hh = lane >> 5;
  const int wm = wid >> 1, wn = wid & 1;
  f32x16 acc[2][2];
#pragma unroll
  for (int i = 0; i < 2; i++)
#pragma unroll
    for (int j = 0; j < 2; j++)
#pragma unroll
      for (int e = 0; e < 16; e++) acc[i][j][e] = 0.f;
  uint4 ra0, ra1, ra2, ra3, rb0, rb1;
  const int lrow = tid >> 3, lc = (tid & 7) * 8;
  const bf16_t* Ap = A + (size_t)(m0 + lrow) * K + lc;
  const bf16_t* Bp = Bt + (size_t)(n0 + lrow) * K + lc;
#define GLOAD(kt)                                                   \
  ra0 = *(const uint4*)(Ap + (size_t)(kt) * 64);                    \
  ra1 = *(const uint4*)(Ap + (size_t)64 * K + (size_t)(kt) * 64);   \
  ra2 = *(const uint4*)(Ap + (size_t)128 * K + (size_t)(kt) * 64);  \
  ra3 = *(const uint4*)(Ap + (size_t)192 * K + (size_t)(kt) * 64);  \
  rb0 = *(const uint4*)(Bp + (size_t)(kt) * 64);                    \
  rb1 = *(const uint4*)(Bp + (size_t)64 * K + (size_t)(kt) * 64);
  const int nk = K / 64;
  GLOAD(0);
  for (int kt = 0; kt < nk; kt++) {
    __syncthreads();
    *(uint4*)(As + (lrow) * GLD + lc) = ra0;
    *(uint4*)(As + (lrow + 64) * GLD + lc) = ra1;
    *(uint4*)(As + (lrow + 128) * GLD + lc) = ra2;
    *(uint4*)(As + (lrow + 192) * GLD + lc) = ra3;
    *(uint4*)(Bs + (lrow) * GLD + lc) = rb0;
    *(uint4*)(Bs + (lrow + 64) * GLD + lc) = rb1;
    __syncthreads();
    if (kt + 1 < nk) { GLOAD(kt + 1); }
#pragma unroll
    for (int s = 0; s < 4; s++) {
      bf16x8 a[2], b[2];
#pragma unroll
      for (int i = 0; i < 2; i++) a[i] = *(const bf16x8*)(As + (wm * 64 + i * 32 + r) * GLD + s * 16 + hh * 8);
#pragma unroll
      for (int j = 0; j < 2; j++) b[j] = *(const bf16x8*)(Bs + (wn * 64 + j * 32 + r) * GLD + s * 16 + hh * 8);
#pragma unroll
      for (int i = 0; i < 2; i++)
#pragma unroll
        for (int j = 0; j < 2; j++)
          acc[i][j] = __builtin_amdgcn_mfma_f32_32x32x16_bf16(a[i], b[j], acc[i][j], 0, 0, 0);
    }
  }
  const float sc = (EPI == 0 && n0 < 512) ? QSCALE : 1.f;
#pragma unroll
  for (int i = 0; i < 2; i++)
#pragma unroll
    for (int j = 0; j < 2; j++)
#pragma unroll
      for (int e = 0; e < 16; e++) {
        const int m = m0 + wm * 64 + i * 32 + (e & 3) + 8 * (e >> 2) + 4 * hh;
        const int n = n0 + wn * 64 + j * 32 + r;
        if (EPI == 0) {
          p.proj[(size_t)m * NPROJ + n] = f2bf(acc[i][j][e] * sc);
        } else {
          p.out[(size_t)m * D_MODEL + n] = p.x[(size_t)m * D_MODEL + n] + acc[i][j][e];
        }
      }
}

#define PLD 132
#define ALD 68
__device__ void gdn_prep(const Params& p, const int task, char* smem) {
  float* qs = (float*)smem;
  float* ks = qs + 64 * PLD;
  float* vs = ks + 64 * PLD;
  float* Am = vs + 64 * PLD;
  float* gs = Am + 64 * ALD;
  float* bs = gs + 64;
  const int tid = threadIdx.x, lane = tid & 63, wid = tid >> 6;
  const int bh = task >> 5, chunk = task & 31, b = bh >> 2, hd = bh & 3;
  const int t0 = chunk * 64;
  const size_t row0 = (size_t)b * T_SEQ + t0;
  __syncthreads();
  for (int idx = tid; idx < 64 * 384; idx += NTHREADS) {
    const int i = idx / 384, ch = idx - i * 384;
    const int which = ch >> 7, d = ch & 127;
    const int cc = which * 512 + hd * 128 + d;
    float acc = 0.f;
#pragma unroll
    for (int tap = 0; tap < 4; tap++) {
      const int tt = t0 + i - 3 + tap;
      if (tt >= 0)
        acc += p.conv_w[tap * 1536 + cc] * bf2f(p.proj[((size_t)b * T_SEQ + tt) * NPROJ + 2048 + cc]);
    }
    const float val = silu_f(acc);
    float* dstp = which == 0 ? qs : (which == 1 ? ks : vs);
    dstp[i * PLD + d] = val;
  }
  __syncthreads();
#pragma unroll 1
  for (int rr = 0; rr < 16; rr++) {
    const int row = wid * 16 + rr;
    float* base = row < 64 ? (qs + row * PLD) : (ks + (row - 64) * PLD);
    const float a = base[lane], c = base[lane + 64];
    const float ss = wave_sum(a * a + c * c);
    const float sc = rsqrtf(ss + EPS) * (row < 64 ? 0.08838834764831845f : 1.f);
    base[lane] = a * sc; base[lane + 64] = c * sc;
  }
  if (wid == 0) {
    const size_t t = row0 + lane;
    const float braw = p.gba[t * 8 + hd], araw = p.gba[t * 8 + 4 + hd];
    const float beta = 1.f / (1.f + __expf(-braw));
    const float xx = araw + p.dt_bias[hd];
    const float sp = fmaxf(xx, 0.f) + log1pf(__expf(-fabsf(xx)));
    float g = -__expf(p.A_log[hd]) * sp;
#pragma unroll
    for (int o = 1; o < 64; o <<= 1) {
      const float u = __shfl_up(g, o);
      if (lane >= o) g += u;
    }
    gs[lane] = g; bs[lane] = beta;
    if (lane == 63) p.eglast[task] = __expf(g);
  }
  __syncthreads();
  {
    const int r = lane & 31, hh = lane >> 5;
    if (wid < 6) {
      const int isAI = wid >= 3, tsel = isAI ? wid - 3 : wid;
      const int ti = tsel == 0 ? 0 : 1, tj = tsel == 2 ? 1 : 0;
      const float* X = isAI ? qs : ks;
      f32x16 acc;
#pragma unroll
      for (int e = 0; e < 16; e++) acc[e] = 0.f;
#pragma unroll 4
      for (int s = 0; s < 16; s++) {
        const float4 xa = *(const float4*)(X + (ti * 32 + r) * PLD + 8 * s + 4 * hh);
        const float4 yb = *(const float4*)(ks + (tj * 32 + r) * PLD + 8 * s + 4 * hh);
        acc = __builtin_amdgcn_mfma_f32_32x32x2f32(xa.x, yb.x, acc, 0, 0, 0);
        acc = __builtin_amdgcn_mfma_f32_32x32x2f32(xa.y, yb.y, acc, 0, 0, 0);
        acc = __builtin_amdgcn_mfma_f32_32x32x2f32(xa.z, yb.z, acc, 0, 0, 0);
        acc = __builtin_amdgcn_mfma_f32_32x32x2f32(xa.w, yb.w, acc, 0, 0, 0);
      }
      const int j = tj * 32 + r;
      const float gj = gs[j];
#pragma unroll
      for (int e = 0; e < 16; e++) {
        const int i = ti * 32 + (e & 3) + 8 * (e >> 2) + 4 * hh;
        const float dec = __expf(fminf(gs[i] - gj, 0.f));
        if (!isAI) {
          Am[j * ALD + i] = (j < i) ? acc[e] * dec * bs[i] : 0.f;
        } else {
          p.AI[(size_t)task * 4096 + i * 64 + j] = f2bf((j <= i) ? acc[e] * dec : 0.f);
        }
      }
    } else if (wid == 6) {
#pragma unroll
      for (int e = 0; e < 16; e++) {
        const int i = (e & 3) + 8 * (e >> 2) + 4 * hh;
        p.AI[(size_t)task * 4096 + i * 64 + 32 + r] = 0;
      }
    }
  }
  __syncthreads();
  {
    const float glast = gs[63];
    for (int idx = tid; idx < 64 * 128; idx += NTHREADS) {
      const int i = idx >> 7, d = idx & 127;
      p.QG[((size_t)bh * T_SEQ + t0 + i) * 128 + d] = f2bf(qs[i * PLD + d] * __expf(gs[i]));
    }
    for (int idx = tid; idx < 64 * 128; idx += NTHREADS) {
      const int d = idx >> 6, i = idx & 63;
      p.KDt[(size_t)task * 8192 + d * 64 + i] = f2bf(ks[i * PLD + d] * __expf(glast - gs[i]));
    }
  }
  __syncthreads();
  if (tid < 256) {
    const int c = tid;
    float* colp = c < 128 ? (vs + c) : (ks + (c - 128));
    bf16_t* dst = (c < 128 ? p.U : p.W) + ((size_t)bh * T_SEQ + t0) * 128 + (c & 127);
#pragma unroll 1
    for (int blk = 0; blk < 4; blk++) {
      float acc[16];
#pragma unroll
      for (int ii = 0; ii < 16; ii++) {
        const int i = blk * 16 + ii;
        float sc = bs[i];
        if (c >= 128) sc *= __expf(gs[i]);
        acc[ii] = colp[i * PLD] * sc;
      }
#pragma unroll 2
      for (int j = 0; j < blk * 16; j++) {
        const float xj = colp[j * PLD];
        const float4* ap = (const float4*)(Am + j * ALD + blk * 16);
        const float4 a0 = ap[0], a1 = ap[1], a2 = ap[2], a3 = ap[3];
        acc[0] -= a0.x * xj; acc[1] -= a0.y * xj; acc[2] -= a0.z * xj; acc[3] -= a0.w * xj;
        acc[4] -= a1.x * xj; acc[5] -= a1.y * xj; acc[6] -= a1.z * xj; acc[7] -= a1.w * xj;
        acc[8] -= a2.x * xj; acc[9] -= a2.y * xj; acc[10] -= a2.z * xj; acc[11] -= a2.w * xj;
        acc[12] -= a3.x * xj; acc[13] -= a3.y * xj; acc[14] -= a3.z * xj; acc[15] -= a3.w * xj;
      }
#pragma unroll
      for (int ii = 1; ii < 16; ii++)
#pragma unroll
        for (int jj = 0; jj < ii; jj++) acc[ii] -= Am[(blk * 16 + jj) * ALD + blk * 16 + ii] * acc[jj];
#pragma unroll
      for (int ii = 0; ii < 16; ii++) {
        colp[(blk * 16 + ii) * PLD] = acc[ii];
        dst[(size_t)(blk * 16 + ii) * 128] = f2bf(acc[ii]);
      }
    }
  }
}

#define SLD 136
#define VLD 72
__device__ void gdn_scan(const Params& p, const int bh, char* smem) {
  bf16_t* St = (bf16_t*)smem;
  bf16_t* vT = St + 128 * SLD;
  bf16_t* wsm = vT + 128 * VLD;
  bf16_t* qgs = wsm + 64 * SLD;
  bf16_t* kdTs = qgs + 64 * SLD;
  bf16_t* AIs = kdTs + 128 * VLD;
  float* obuf = (float*)wsm;
  const int tid = threadIdx.x, lane = tid & 63, wid = tid >> 6;
  const int r = lane & 31, hh = lane >> 5;
  const int mi = wid & 1, ni = wid >> 1;
  const int b = bh >> 2, hd = bh & 3;
  f32x16 accS[2];
#pragma unroll
  for (int q = 0; q < 2; q++)
#pragma unroll
    for (int e = 0; e < 16; e++) accS[q][e] = 0.f;
  __syncthreads();
  for (int idx = tid; idx < 128 * SLD / 2; idx += NTHREADS) ((unsigned*)St)[idx] = 0u;

  for (int n = 0; n < 32; n++) {
    const int task = bh * 32 + n;
    const size_t trow = (size_t)bh * T_SEQ + n * 64;
    __syncthreads();
#pragma unroll
    for (int it = 0; it < 2; it++) {
      const int idx = tid + it * NTHREADS, row = idx >> 4, c = (idx & 15) * 8;
      *(uint4*)(wsm + row * SLD + c) = *(const uint4*)(p.W + (trow + row) * 128 + c);
      *(uint4*)(qgs + row * SLD + c) = *(const uint4*)(p.QG + (trow + row) * 128 + c);
    }
#pragma unroll
    for (int it = 0; it < 2; it++) {
      const int idx = tid + it * NTHREADS, row = idx >> 3, c = (idx & 7) * 8;
      *(uint4*)(kdTs + row * VLD + c) = *(const uint4*)(p.KDt + (size_t)task * 8192 + row * 64 + c);
    }
    {
      const int row = tid >> 3, c = (tid & 7) * 8;
      *(uint4*)(AIs + row * VLD + c) = *(const uint4*)(p.AI + (size_t)task * 4096 + row * 64 + c);
    }
    float uu[16];
#pragma unroll
    for (int e = 0; e < 16; e++) {
      const int tok = mi * 32 + (e & 3) + 8 * (e >> 2) + 4 * hh;
      uu[e] = bf2f(p.U[(trow + tok) * 128 + ni * 32 + r]);
    }
    const float eg = p.eglast[task];
    __syncthreads();
    f32x16 accv, acco;
#pragma unroll
    for (int e = 0; e < 16; e++) { accv[e] = 0.f; acco[e] = 0.f; }
#pragma unroll
    for (int s = 0; s < 8; s++) {
      const bf16x8 bS = *(const bf16x8*)(St + (ni * 32 + r) * SLD + s * 16 + hh * 8);
      const bf16x8 aW = *(const bf16x8*)(wsm + (mi * 32 + r) * SLD + s * 16 + hh * 8);
      const bf16x8 aQ = *(const bf16x8*)(qgs + (mi * 32 + r) * SLD + s * 16 + hh * 8);
      accv = __builtin_amdgcn_mfma_f32_32x32x16_bf16(aW, bS, accv, 0, 0, 0);
      acco = __builtin_amdgcn_mfma_f32_32x32x16_bf16(aQ, bS, acco, 0, 0, 0);
    }
#pragma unroll
    for (int g = 0; g < 4; g++) {
      bf16x4 pk;
#pragma unroll
      for (int i = 0; i < 4; i++) pk[i] = (short)f2bf(uu[4 * g + i] - accv[4 * g + i]);
      *(bf16x4*)(vT + (ni * 32 + r) * VLD + mi * 32 + 8 * g + 4 * hh) = pk;
    }
    __syncthreads();
    bf16x8 bV[4];
#pragma unroll
    for (int s = 0; s < 4; s++) bV[s] = *(const bf16x8*)(vT + (ni * 32 + r) * VLD + s * 16 + hh * 8);
#pragma unroll
    for (int s = 0; s < 4; s++) {
      const bf16x8 aA = *(const bf16x8*)(AIs + (mi * 32 + r) * VLD + s * 16 + hh * 8);
      acco = __builtin_amdgcn_mfma_f32_32x32x16_bf16(aA, bV[s], acco, 0, 0, 0);
    }
#pragma unroll
    for (int q = 0; q < 2; q++) {
      const int dkb = 2 * mi + q;
#pragma unroll
      for (int e = 0; e < 16; e++) accS[q][e] *= eg;
#pragma unroll
      for (int s = 0; s < 4; s++) {
        const bf16x8 aK = *(const bf16x8*)(kdTs + (dkb * 32 + r) * VLD + s * 16 + hh * 8);
        accS[q] = __builtin_amdgcn_mfma_f32_32x32x16_bf16(aK, bV[s], accS[q], 0, 0, 0);
      }
#pragma unroll
      for (int g = 0; g < 4; g++) {
        bf16x4 pk;
#pragma unroll
        for (int i = 0; i < 4; i++) pk[i] = (short)f2bf(accS[q][4 * g + i]);
        *(bf16x4*)(St + (ni * 32 + r) * SLD + dkb * 32 + 8 * g + 4 * hh) = pk;
      }
    }
#pragma unroll
    for (int e = 0; e < 16; e++) {
      const int tok = mi * 32 + (e & 3) + 8 * (e >> 2) + 4 * hh;
      obuf[tok * PLD + ni * 32 + r] = acco[e];
    }
    __syncthreads();
#pragma unroll 1
    for (int rr = 0; rr < 8; rr++) {
      const int tok = wid * 8 + rr;
      const float a = obuf[tok * PLD + lane], c = obuf[tok * PLD + lane + 64];
      const float ss = wave_sum(a * a + c * c);
      const float rstd = rsqrtf(ss * (1.f / 128.f) + EPS);
      const size_t grow = (size_t)b * T_SEQ + n * 64 + tok;
      const float z0 = bf2f(p.proj[grow * NPROJ + 3584 + hd * 128 + lane]);
      const float z1 = bf2f(p.proj[grow * NPROJ + 3584 + hd * 128 + lane + 64]);
      p.mixed[grow * D_MODEL + 512 + hd * 128 + lane] = f2bf(a * rstd * p.gdn_norm_w[lane] * silu_f(z0));
      p.mixed[grow * D_MODEL + 512 + hd * 128 + lane + 64] = f2bf(c * rstd * p.gdn_norm_w[lane + 64] * silu_f(z1));
    }
  }
}

#define KLD 72
__device__ void attn_tile(const Params& p, const int bh, const int qb, char* smem) {
  bf16_t* Ks = (bf16_t*)smem;
  bf16_t* Vt = Ks + 64 * KLD;
  const int tid = threadIdx.x, lane = tid & 63, wid = tid >> 6;
  const int r = lane & 31, hh = lane >> 5;
  const int b = bh >> 3, hd = bh & 7;
  const int q0 = qb * 256;
  const int tq = q0 + wid * 32 + r;
  const size_t qrow = (size_t)b * T_SEQ + tq;
  bf16x8 bQ[4];
#pragma unroll
  for (int s = 0; s < 4; s++) bQ[s] = *(const bf16x8*)(p.proj + qrow * NPROJ + hd * 64 + s * 16 + hh * 8);
  f32x16 O[2];
#pragma unroll
  for (int i = 0; i < 2; i++)
#pragma unroll
    for (int e = 0; e < 16; e++) O[i][e] = 0.f;
  float R = 1.f;
  const int tmin = q0 + wid * 32;
  const int lkey = tid >> 3, lc = (tid & 7) * 8;
  for (int kt = qb * 4 + 3; kt >= 0; kt--) {
    const int k0 = kt * 64;
    __syncthreads();
    {
      const size_t krow = ((size_t)b * T_SEQ + k0 + lkey) * NPROJ;
      const uint4 kv = *(const uint4*)(p.proj + krow + 512 + hd * 64 + lc);
      const uint4 vv = *(const uint4*)(p.proj + krow + 1024 + hd * 64 + lc);
      *(uint4*)(Ks + lkey * KLD + lc) = kv;
      const unsigned vw[4] = {vv.x, vv.y, vv.z, vv.w};
#pragma unroll
      for (int e = 0; e < 4; e++) {
        Vt[(lc + 2 * e) * KLD + lkey] = (bf16_t)(vw[e] & 0xffffu);
        Vt[(lc + 2 * e + 1) * KLD + lkey] = (bf16_t)(vw[e] >> 16);
      }
    }
    __syncthreads();
    if (k0 > tmin + 30) continue;
    const bool diag = (k0 + 63 >= tmin);
#pragma unroll
    for (int kb = 1; kb >= 0; kb--) {
      f32x16 z;
#pragma unroll
      for (int e = 0; e < 16; e++) z[e] = 0.f;
#pragma unroll
      for (int s = 0; s < 4; s++) {
        const bf16x8 aK = *(const bf16x8*)(Ks + (kb * 32 + r) * KLD + s * 16 + hh * 8);
        z = __builtin_amdgcn_mfma_f32_32x32x16_bf16(aK, bQ[s], z, 0, 0, 0);
      }
      float ev[16], fv[16];
#pragma unroll
      for (int e = 0; e < 16; e++) {
        float ex = __builtin_amdgcn_exp2f(fminf(z[e], 100.f));
        if (diag) {
          const int key = k0 + kb * 32 + (e & 3) + 8 * (e >> 2) + 4 * hh;
          if (key >= tq) ex = 0.f;
        }
        ev[e] = ex;
        fv[e] = __builtin_amdgcn_rcpf(1.f + ex);
      }
      float pv[16];
#pragma unroll
      for (int g = 3; g >= 0; g--) {
        const float s3 = fv[4 * g + 3];
        const float s2 = fv[4 * g + 2] * s3;
        const float s1 = fv[4 * g + 1] * s2;
        const float s0 = fv[4 * g] * s1;
        const float Lp = __shfl_xor(s0, 32);
        const float c = hh ? R : R * Lp;
        pv[4 * g + 3] = ev[4 * g + 3] * s3 * c;
        pv[4 * g + 2] = ev[4 * g + 2] * s2 * c;
        pv[4 * g + 1] = ev[4 * g + 1] * s1 * c;
        pv[4 * g] = ev[4 * g] * s0 * c;
        R = R * s0 * Lp;
      }
#pragma unroll
      for (int s = 0; s < 2; s++) {
        bf16x8 pf;
#pragma unroll
        for (int j = 0; j < 8; j++) pf[j] = (short)f2bf(pv[8 * s + j]);
#pragma unroll
        for (int m2 = 0; m2 < 2; m2++) {
          const bf16_t* vp = Vt + (m2 * 32 + r) * KLD + kb * 32 + 16 * s + 4 * hh;
          const bf16x4 lo = *(const bf16x4*)vp;
          const bf16x4 hi = *(const bf16x4*)(vp + 8);
          bf16x8 aV;
          aV[0] = lo[0]; aV[1] = lo[1]; aV[2] = lo[2]; aV[3] = lo[3];
          aV[4] = hi[0]; aV[5] = hi[1]; aV[6] = hi[2]; aV[7] = hi[3];
          O[m2] = __builtin_amdgcn_mfma_f32_32x32x16_bf16(aV, pf, O[m2], 0, 0, 0);
        }
      }
    }
  }
  float ss = 0.f;
#pragma unroll
  for (int i = 0; i < 2; i++)
#pragma unroll
    for (int e = 0; e < 16; e++) ss += O[i][e] * O[i][e];
  ss += __shfl_xor(ss, 32);
  const float rstd = rsqrtf(ss * (1.f / 64.f) + EPS);
#pragma unroll
  for (int i = 0; i < 2; i++)
#pragma unroll
    for (int g = 0; g < 4; g++) {
      const int d0 = i * 32 + 8 * g + 4 * hh;
      const bf16x4 zz = *(const bf16x4*)(p.proj + qrow * NPROJ + 1536 + hd * 64 + d0);
      const float4 nw = *(const float4*)(p.sb_norm_w + d0);
      const float nwv[4] = {nw.x, nw.y, nw.z, nw.w};
      bf16x4 ob;
#pragma unroll
      for (int c = 0; c < 4; c++)
        ob[c] = (short)f2bf(O[i][4 * g + c] * rstd * nwv[c] * silu_f(bf2f((bf16_t)zz[c])));
      *(bf16x4*)(p.mixed + qrow * D_MODEL + hd * 64 + d0) = ob;
    }
}

__device__ void final_norm(const Params& p) {
  const int tid = threadIdx.x, lane = tid & 63, wid = tid >> 6;
  const int gw = blockIdx.x * 8 + wid, nw = gridDim.x * 8;
  for (int row = gw; row < M_TOK; row += nw) {
    float4* yr = (float4*)(p.out + (size_t)row * D_MODEL);
    float4 v[4];
    float ss = 0.f;
#pragma unroll
    for (int i = 0; i < 4; i++) {
      v[i] = yr[lane + 64 * i];
      ss += v[i].x * v[i].x + v[i].y * v[i].y + v[i].z * v[i].z + v[i].w * v[i].w;
    }
    ss = wave_sum(ss);
    const float rstd = rsqrtf(ss * (1.f / D_MODEL) + EPS);
#pragma unroll
    for (int i = 0; i < 4; i++) {
      const float4 w = ((const float4*)p.final_w)[lane + 64 * i];
      float4 o;
      o.x = v[i].x * rstd * w.x; o.y = v[i].y * rstd * w.y; o.z = v[i].z * rstd * w.z; o.w = v[i].w * rstd * w.w;
      yr[lane + 64 * i] = o;
    }
  }
}

#define SMEM_BYTES (128 * 1024)
__global__ void __launch_bounds__(NTHREADS) fwd_megakernel(Params p) {
  extern __shared__ __attribute__((aligned(16))) char smem[];
  cg::grid_group grid = cg::this_grid();
  __shared__ int s_item;

#ifndef NO_P0
  phase0(p, smem);
#endif
  grid.sync();
  for (int t = blockIdx.x; t < 64 * 32; t += gridDim.x)
#ifndef NO_G0
    gemm_tile<0>(p, p.h, p.Wt, 1024, (t >> 5) * 256, (t & 31) * 128, smem);
#endif
  grid.sync();
#ifndef NO_PREP
  for (int t = blockIdx.x; t < 1024; t += gridDim.x) gdn_prep(p, t, smem);
#endif
  grid.sync();
  for (;;) {
    __syncthreads();
    if (threadIdx.x == 0) s_item = (int)atomicAdd(&p.counters[0], 1u);
    __syncthreads();
    const int item = s_item;
    if (item >= 32 + 512) break;
#ifndef NO_SCAN
    if (item < 32) gdn_scan(p, item, smem);
#endif
#ifndef NO_ATTN
    if (item >= 32) { const int j = item - 32; attn_tile(p, j & 63, 7 - (j >> 6), smem); }
#endif
  }
  grid.sync();
  for (int t = blockIdx.x; t < 64 * 8; t += gridDim.x)
#ifndef NO_G1
    gemm_tile<1>(p, p.mixed, p.WoT, 1024, (t >> 3) * 256, (t & 7) * 128, smem);
#endif
  grid.sync();
  final_norm(p);
}

extern "C" void kernel_launch(void* const* d_in, const int* in_sizes, int n_in, void* d_out, int out_size,
                              void* d_ws, size_t ws_size, hipStream_t stream) {
  static int grid_blocks = 0;
  if (!grid_blocks) {
    int dev = 0, cus = 0, per_cu = 0;
    hipGetDevice(&dev);
    hipDeviceGetAttribute(&cus, hipDeviceAttributeMultiprocessorCount, dev);
    hipFuncSetAttribute((const void*)fwd_megakernel, hipFuncAttributeMaxDynamicSharedMemorySize, SMEM_BYTES);
    hipOccupancyMaxActiveBlocksPerMultiprocessor(&per_cu, fwd_megakernel, NTHREADS, SMEM_BYTES);
    if (per_cu < 1) per_cu = 1;
    grid_blocks = cus * per_cu;
  }
  Params p{};
  p.x = (const float*)d_in[0]; p.norm1_w = (const float*)d_in[1]; p.w_in = (const float*)d_in[2];
  p.sb_norm_w = (const float*)d_in[3]; p.conv_w = (const float*)d_in[4]; p.A_log = (const float*)d_in[5];
  p.dt_bias = (const float*)d_in[6]; p.gdn_norm_w = (const float*)d_in[7]; p.w_out = (const float*)d_in[8];
  p.final_w = (const float*)d_in[9];
  p.out = (float*)d_out;
  char* ws = (char*)d_ws;
  const size_t MiB = 1024 * 1024;
  p.Wt = (bf16_t*)(ws + 0 * MiB);
  p.WoT = (bf16_t*)(ws + 8 * MiB);
  p.gba = (float*)(ws + 10 * MiB);
  p.counters = (unsigned*)(ws + 10 * MiB + 512 * 1024);
  p.eglast = (float*)(ws + 10 * MiB + 512 * 1024 + 4096);
  p.h = (bf16_t*)(ws + 11 * MiB);
  p.mixed = (bf16_t*)(ws + 11 * MiB);
  p.proj = (bf16_t*)(ws + 43 * MiB);
  p.U = (bf16_t*)(ws + 171 * MiB);
  p.W = (bf16_t*)(ws + 187 * MiB);
  p.QG = (bf16_t*)(ws + 203 * MiB);
  p.KDt = (bf16_t*)(ws + 219 * MiB);
  p.AI = (bf16_t*)(ws + 235 * MiB);
  void* args[] = {&p};
  hipError_t e = hipLaunchCooperativeKernel((void*)fwd_megakernel, dim3(grid_blocks), dim3(NTHREADS), args,
                                            SMEM_BYTES, stream);
  if (e != hipSuccess) fprintf(stderr, "cooperative launch failed: %s (grid %d)\n", hipGetErrorString(e), grid_blocks);
}
```

```cpp
#include <hip/hip_runtime.h>
#include <hip/hip_bf16.h>
#include <hip/hip_cooperative_groups.h>
#include <cstdio>
namespace cg = cooperative_groups;

typedef unsigned short bf16_t;
using bf16x8 = __attribute__((ext_vector_type(8))) short;
using bf16x4 = __attribute__((ext_vector_type(4))) short;
using f32x16 = __attribute__((ext_vector_type(16))) float;
using f32x4 = __attribute__((ext_vector_type(4))) float;

#define NTHREADS 512
#define CTRL_OFF (152 * 1024 - 64)
#define DYN_QUEUE 1
#define M_TOK 16384
#define T_SEQ 2048
#define D_MODEL 1024
#define D_IN 4104
#define NPROJ 4096
#define EPS 1e-6f
#define QSCALE 0.18033688011112042f
#define ATTN_DEAD 1e-12f
#ifndef SCAN_AT
#define SCAN_AT 512
#endif

struct Params {
  const float* x; const float* norm1_w; const float* w_in; const float* sb_norm_w;
  const float* conv_w; const float* A_log; const float* dt_bias; const float* gdn_norm_w;
  const float* w_out; const float* final_w;
  float* out;
  bf16_t* Wt; bf16_t* WoT; float* gba; unsigned* counters; float* eglast;
  bf16_t* h; bf16_t* mixed; bf16_t* proj;
  bf16_t* U; bf16_t* W; bf16_t* QG; bf16_t* KDt; bf16_t* AI;
  unsigned* bar; unsigned* flags; float* rowss; unsigned* pcnt; unsigned coop_flag; unsigned pad_;
};

__device__ __forceinline__ bf16_t f2bf(float f) { return __builtin_bit_cast(unsigned short, (__bf16)f); }
__device__ __forceinline__ float bf2f(bf16_t b) { return __uint_as_float(((unsigned)b) << 16); }
template <int CTRL> __device__ __forceinline__ float dpp_mov(float v) {
  return __int_as_float(__builtin_amdgcn_update_dpp(0, __float_as_int(v), CTRL, 0xf, 0xf, true));
}
__device__ __forceinline__ float row16_sum(float v) {
  v += dpp_mov<0xB1>(v);
  v += dpp_mov<0x4E>(v);
  v += dpp_mov<0x141>(v);
  v += dpp_mov<0x140>(v);
  return v;
}
__device__ __forceinline__ float xchg32(float x, int hh);
__device__ __forceinline__ float wave_sum(float v) {
  v = row16_sum(v);
  v += __shfl_xor(v, 16);
  v += xchg32(v, (int)(threadIdx.x & 63) >> 5);
  return v;
}
__device__ __forceinline__ float xchg32(float x, int hh) {
  const unsigned u = __float_as_uint(x);
  const auto r = __builtin_amdgcn_permlane32_swap(u, u, false, false);
  return __uint_as_float(hh ? r[0] : r[1]);
}
__device__ __forceinline__ float silu_f(float x) { return x * __builtin_amdgcn_rcpf(1.f + __expf(-x)); }
typedef __bf16 bf16x2_nat __attribute__((ext_vector_type(2)));
__device__ __forceinline__ unsigned cvt_pk_bf16(float lo, float hi) {
  bf16x2_nat v;
  v[0] = (__bf16)lo; v[1] = (__bf16)hi;
  return __builtin_bit_cast(unsigned, v);
}

typedef unsigned u32x4_t __attribute__((ext_vector_type(4)));
__device__ __forceinline__ void st_wt_b128(void* ptr, unsigned a, unsigned b, unsigned c, unsigned d) {
  u32x4_t v = {a, b, c, d};
  asm volatile("global_store_dwordx4 %0, %1, off sc1\n\ts_nop 1" :: "v"(ptr), "v"(v) : "memory");
}
__device__ __forceinline__ void st_wt_b32(void* ptr, unsigned v) {
  asm volatile("global_store_dword %0, %1, off sc1" :: "v"(ptr), "v"(v) : "memory");
}
__device__ __forceinline__ void st_wt_b16(void* ptr, unsigned v) {
  asm volatile("global_store_short %0, %1, off sc1" :: "v"(ptr), "v"(v) : "memory");
}

#define XB_TMO      128
#define XB_XCNT(j)  (256  + 64 * (j))
#define XB_XSUB(j)  (1280 + 64 * (j))
#define XB_XGEN(j)  (2304 + 64 * (j))
#define XB_TOP      3328
#define XB_TOPGEN   3392
#define XCD_BAR_WORDS 3456
#define XB_SPIN_CAP (1u << 18)
#define LAS __attribute__((address_space(3)))

__device__ __forceinline__ unsigned xb_ld(unsigned* p)              { return __hip_atomic_load(p, __ATOMIC_RELAXED, __HIP_MEMORY_SCOPE_AGENT); }
__device__ __forceinline__ unsigned xb_add(unsigned* p, unsigned v) { return __hip_atomic_fetch_add(p, v, __ATOMIC_RELAXED, __HIP_MEMORY_SCOPE_AGENT); }
__device__ __forceinline__ unsigned xb_xcc_id() { return (unsigned)__builtin_amdgcn_s_getreg((3 << 11) | 20) & 0xFu; }
#define XB_SPIN(cond, bar) do { unsigned _sp = 0; while (cond) { __builtin_amdgcn_s_sleep(1); \
    if ((++_sp & 255u) == 0u) { if (xb_ld(&(bar)[XB_TMO])) break; if (_sp > XB_SPIN_CAP) { atomicAdd(&(bar)[XB_TMO], 1u); break; } } } } while (0)

struct XcdBarrier {
    unsigned* bar; unsigned x;
    volatile LAS unsigned* st;
};

__device__ __forceinline__ XcdBarrier xcd_barrier_post(unsigned* bar, volatile LAS unsigned* st) {
    XcdBarrier b; b.bar = bar; b.x = xb_xcc_id(); b.st = st;
    if (threadIdx.x == 0) (void)xb_add(&bar[XB_XCNT(b.x)], 1u);
    return b;
}
__device__ __forceinline__ void xcd_barrier_complete(unsigned* bar, unsigned x, unsigned& nloc, unsigned& nx) {
    const unsigned G = gridDim.x * gridDim.y * gridDim.z;
    unsigned sum, cnt, mine, sp = 0u;
    for (;;) {
        sum = 0u; cnt = 0u; mine = 0u;
#pragma unroll
        for (unsigned j = 0; j < 16; ++j) { const unsigned c = xb_ld(&bar[XB_XCNT(j)]); sum += c; cnt += (c > 0u) ? 1u : 0u; mine = (j == x) ? c : mine; }
        if (sum == G) break;
        __builtin_amdgcn_s_sleep(1);
        if ((++sp & 255u) == 0u) { if (xb_ld(&bar[XB_TMO])) break; if (sp > XB_SPIN_CAP) { atomicAdd(&bar[XB_TMO], 1u); break; } }
    }
    nloc = mine > 0u ? mine : 1u; nx = cnt > 0u ? cnt : 1u;
}

__device__ __forceinline__ void xcd_barrier(const XcdBarrier& b) {
    asm volatile("s_waitcnt vmcnt(0)" ::: "memory");
    __syncthreads();
    if (threadIdx.x == 0) {
        unsigned* bar = b.bar;
        __builtin_amdgcn_s_waitcnt(0);
        unsigned nloc = b.st[0], nx = b.st[1];
        if (nloc == 0u) { xcd_barrier_complete(bar, b.x, nloc, nx); b.st[0] = nloc; b.st[1] = nx; }
        const unsigned old = xb_add(&bar[XB_XSUB(b.x)], 1u);
        const unsigned gen = old / nloc;
        if (old + 1u == (gen + 1u) * nloc) {
            __builtin_amdgcn_fence(__ATOMIC_RELEASE, "agent");
            asm volatile("s_waitcnt vmcnt(0)" ::: "memory");
            const unsigned og = xb_add(&bar[XB_TOP], 1u);
            const unsigned tg = og / nx;
            if (og + 1u == (tg + 1u) * nx) xb_add(&bar[XB_TOPGEN], 1u);
            else XB_SPIN(xb_ld(&bar[XB_TOPGEN]) == tg, bar);
            __builtin_amdgcn_fence(__ATOMIC_ACQUIRE, "agent");
            xb_add(&bar[XB_XGEN(b.x)], 1u);
            asm volatile("s_waitcnt vmcnt(0)" ::: "memory");
        } else {
            XB_SPIN(xb_ld(&bar[XB_XGEN(b.x)]) == gen, bar);
            __builtin_amdgcn_fence(__ATOMIC_ACQUIRE, "agent");
            asm volatile("s_waitcnt vmcnt(0)" ::: "memory");
        }
    }
    __syncthreads();
}


__device__ void phase0(const Params& p, char* smem) {
  const int tid = threadIdx.x, lane = tid & 63, wid = tid >> 6;
  float* wg = (float*)(smem + 32768);
  for (int k = tid; k < 1024; k += NTHREADS) {
    const float4* wp = (const float4*)(p.w_in + (size_t)k * D_IN + NPROJ);
    const float4 wa = wp[0], wb = wp[1];
    wg[0 * 1024 + k] = wa.x; wg[1 * 1024 + k] = wa.y; wg[2 * 1024 + k] = wa.z; wg[3 * 1024 + k] = wa.w;
    wg[4 * 1024 + k] = wb.x; wg[5 * 1024 + k] = wb.y; wg[6 * 1024 + k] = wb.z; wg[7 * 1024 + k] = wb.w;
  }
  __syncthreads();
  const int gw = blockIdx.x * 8 + wid, nw = gridDim.x * 8;
#pragma unroll 2
  for (int row = gw; row < M_TOK; row += nw) {
    const float4* xr = (const float4*)(p.x + (size_t)row * D_MODEL);
    float4 v[4];
    float ss = 0.f;
#pragma unroll
    for (int i = 0; i < 4; i++) {
      v[i] = xr[lane + 64 * i];
      ss += v[i].x * v[i].x + v[i].y * v[i].y + v[i].z * v[i].z + v[i].w * v[i].w;
    }
    ss = wave_sum(ss);
    const float rstd = rsqrtf(ss * (1.f / D_MODEL) + EPS);
    float a[8];
#pragma unroll
    for (int c = 0; c < 8; c++) a[c] = 0.f;
#pragma unroll
    for (int i = 0; i < 4; i++) {
      const float4 w = ((const float4*)p.norm1_w)[lane + 64 * i];
      float hv[4];
      hv[0] = v[i].x * rstd * w.x; hv[1] = v[i].y * rstd * w.y;
      hv[2] = v[i].z * rstd * w.z; hv[3] = v[i].w * rstd * w.w;
      bf16x4 hb;
      hb[0] = (short)f2bf(hv[0]); hb[1] = (short)f2bf(hv[1]); hb[2] = (short)f2bf(hv[2]); hb[3] = (short)f2bf(hv[3]);
      *(bf16x4*)(p.h + (size_t)row * D_MODEL + (lane + 64 * i) * 4) = hb;
#pragma unroll
      for (int c = 0; c < 8; c++) {
        const float4 wv = *(const float4*)(wg + c * 1024 + (lane + 64 * i) * 4);
        a[c] += hv[0] * wv.x + hv[1] * wv.y + hv[2] * wv.z + hv[3] * wv.w;
      }
    }
#pragma unroll
    for (int c = 0; c < 8; c++) a[c] = wave_sum(a[c]);
    if (lane == 0) {
      float4* g = (float4*)(p.gba + (size_t)row * 8);
      g[0] = make_float4(a[0], a[1], a[2], a[3]);
      g[1] = make_float4(a[4], a[5], a[6], a[7]);
    }
  }
  float* tile = (float*)smem;
  const int tx = tid & 63, ty = tid >> 6;
  for (int t = blockIdx.x; t < 1280; t += gridDim.x) {
    const float* src; bf16_t* dst; int ld, k0, n0;
    if (t < 1024) { src = p.w_in; ld = D_IN; k0 = (t >> 6) * 64; n0 = (t & 63) * 64; dst = p.Wt; }
    else { const int u = t - 1024; src = p.w_out; ld = 1024; k0 = (u >> 4) * 64; n0 = (u & 15) * 64; dst = p.WoT; }
#pragma unroll
    for (int it = 0; it < 2; it++) {
      const int idx = tid + it * NTHREADS, k = idx >> 4, n4 = (idx & 15) * 4;
      const float4 v4 = *(const float4*)(src + (size_t)(k0 + k) * ld + n0 + n4);
      float* tp = tile + k * 65 + n4;
      tp[0] = v4.x; tp[1] = v4.y; tp[2] = v4.z; tp[3] = v4.w;
    }
    __syncthreads();
#pragma unroll
    for (int it = 0; it < 2; it++) {
      const int idx = tid + it * NTHREADS, n = idx >> 4, k4 = (idx & 15) * 4;
      const float* tp = tile + k4 * 65 + n;
      *(uint2*)(dst + (size_t)(n0 + n) * 1024 + k0 + k4) = make_uint2(cvt_pk_bf16(tp[0], tp[65]), cvt_pk_bf16(tp[130], tp[195]));
    }
    __syncthreads();
  }
}

#include <hip/hip_runtime.h>
namespace pg8 {
#define PG8_LAS __attribute__((address_space(3)))
typedef unsigned short bf16_t;
typedef short bf16x8 __attribute__((ext_vector_type(8)));
typedef float f32x4 __attribute__((ext_vector_type(4)));
typedef unsigned u32x4 __attribute__((ext_vector_type(4)));
constexpr int BM = 256, BK = 64, HALF = 128, HTB = HALF * BK * 2  , STAGE_BYTES = 8 * HTB, NXCD = 8, WGM = 8;

__host__ __device__ __forceinline__ int lds_byte(int r, int c) { const int st = (r >> 4) * 2 + (c >> 5), rr = r & 15, cc = c & 31, ob = rr * 64 + cc * 2; return st * 1024 + (ob ^ (((ob >> 9) & 1) << 5)); }
__host__ __device__ __forceinline__ void stage_rc(int b, int& R, int& C) { const int st = b / 1024, sb = b % 1024, swz = sb ^ (((sb >> 9) & 1) << 5); R = (st >> 1) * 16 + swz / 64; C = (st & 1) * 32 + (swz % 64) / 2; }
__host__ __device__ __forceinline__ int perm32(int rho) { const int n = rho >> 4, i = rho & 15; return 8 * (i >> 2) + 4 * n + (i & 3); }

struct Unit { int pm, pn; };
struct Gemm { const bf16_t* A; const bf16_t* Bt; int M, N, K; };

struct StaticOrder {
    int nM, nN, nwg, G, c;
    __host__ __device__ void init(int M, int N, int G_, int c_) { nM = M / BM; nN = N / BM; nwg = nM * nN; G = G_; c = c_; }
    __host__ __device__ bool next(int i, Unit& u) const {
        const long L = (long)i * G + c; if (L >= nwg) return false;
        int wgid = (int)L; { const int q = nwg / NXCD, r = nwg % NXCD, xcd = wgid % NXCD, off = wgid / NXCD; wgid = (xcd < r ? xcd * (q + 1) : r * (q + 1) + (xcd - r) * q) + off; }
        const int nig = WGM * nN, gid = wgid / nig, fm = gid * WGM, gsz = (nM - fm) < WGM ? (nM - fm) : WGM;
        u.pm = fm + ((wgid % nig) % gsz); u.pn = (wgid % nig) / gsz; return true;
    }
    __device__ __forceinline__ void a_ready(const Unit&) const {}
    __device__ __forceinline__ void done(const Unit&) const {}
};
__device__ __forceinline__ unsigned cvt_pk_bf16(float lo, float hi) { unsigned r; asm volatile("v_cvt_pk_bf16_f32 %0, %1, %2" : "=v"(r) : "v"(lo), "v"(hi)); return r; }

struct EpiProj {
    static constexpr bool PERM = true, AFTER_DRAIN = false;
    bf16_t* O;
    __device__ __forceinline__ void operator()(const f32x4 (&acc)[2][2][4][2], const Unit& u, int wr, int wc, int fr, int fq) const {
        const int row0 = u.pm * BM + wr * 64 + fr; const int colt = u.pn * BM;
        const int col0 = colt + wc * 32 + 8 * fq;
        const float sc = colt < 512 ? 0.18033688011112042f : 1.f;
        if (colt >= 1024 && colt < 1536) {
#pragma unroll
            for (int ai = 0; ai < 2; ++ai)
#pragma unroll
                for (int m = 0; m < 4; ++m) { const int tok = row0 + ai * HALF + m * 16, tb = tok & ~63, tl = tok & 63;
#pragma unroll
                    for (int bj = 0; bj < 2; ++bj) { const int hc = col0 + bj * HALF - 1024, hd = hc >> 6, d0 = hc & 63;
                        bf16_t* bp = O + (size_t)(tb + d0) * 4096 + 1024 + hd * 64 + tl;
                        const f32x4 v0 = acc[ai][bj][m][0], v1 = acc[ai][bj][m][1];
                        const unsigned w0 = cvt_pk_bf16(v0[0], v0[1]), w1 = cvt_pk_bf16(v0[2], v0[3]), w2 = cvt_pk_bf16(v1[0], v1[1]), w3 = cvt_pk_bf16(v1[2], v1[3]);
                        bp[0 * 4096] = (bf16_t)(w0 & 0xffffu); bp[1 * 4096] = (bf16_t)(w0 >> 16);
                        bp[2 * 4096] = (bf16_t)(w1 & 0xffffu); bp[3 * 4096] = (bf16_t)(w1 >> 16);
                        bp[4 * 4096] = (bf16_t)(w2 & 0xffffu); bp[5 * 4096] = (bf16_t)(w2 >> 16);
                        bp[6 * 4096] = (bf16_t)(w3 & 0xffffu); bp[7 * 4096] = (bf16_t)(w3 >> 16); } }
            return;
        }
#pragma unroll
        for (int ai = 0; ai < 2; ++ai)
#pragma unroll
            for (int m = 0; m < 4; ++m) { bf16_t* rowp = O + (size_t)(row0 + ai * HALF + m * 16) * 4096 + col0;
#pragma unroll
                for (int bj = 0; bj < 2; ++bj) { const f32x4 v0 = acc[ai][bj][m][0] * sc, v1 = acc[ai][bj][m][1] * sc;
                    u32x4 w; w.x = cvt_pk_bf16(v0[0], v0[1]); w.y = cvt_pk_bf16(v0[2], v0[3]); w.z = cvt_pk_bf16(v1[0], v1[1]); w.w = cvt_pk_bf16(v1[2], v1[3]);
                    *(u32x4*)(rowp + bj * HALF) = w; } }
    }
};
struct EpiOut {
    static constexpr bool PERM = false, AFTER_DRAIN = false;
    float* C; const float* X;
    __device__ __forceinline__ void operator()(const f32x4 (&acc)[2][2][4][2], const Unit& u, int wr, int wc, int fr, int fq) const {
        const int row0 = u.pm * BM + wr * 64 + fr, col0 = u.pn * BM + wc * 32 + 4 * fq;
#pragma unroll
        for (int ai = 0; ai < 2; ++ai)
#pragma unroll
            for (int m = 0; m < 4; ++m) { const size_t off = (size_t)(row0 + ai * HALF + m * 16) * 1024 + col0;
#pragma unroll
                for (int bj = 0; bj < 2; ++bj)
#pragma unroll
                    for (int n = 0; n < 2; ++n) *(f32x4*)(C + off + bj * HALF + n * 16) = acc[ai][bj][m][n] + *(const f32x4*)(X + off + bj * HALF + n * 16); }
    }
};

struct EpiOutNorm {
    static constexpr bool PERM = false, AFTER_DRAIN = true;
    float* C; const float* X; const float* FW; float* rowss; unsigned* cnt;
    __device__ __forceinline__ void operator()(const f32x4 (&)[2][2][4][2], const Unit&, int, int, int, int) const {}
    __device__ __forceinline__ void fused(f32x4 (&acc)[2][2][4][2], const Unit& u, int wr, int wc, int fr, int fq, PG8_LAS unsigned char* lds, int wid, int lane) const {
        PG8_LAS float* ls = (PG8_LAS float*)lds;
        const int tid = threadIdx.x;
        const int row0 = u.pm * BM + wr * 64 + fr, col0 = u.pn * BM + wc * 32 + 4 * fq;
#pragma unroll
        for (int ai = 0; ai < 2; ++ai)
#pragma unroll
            for (int m = 0; m < 4; ++m) { const size_t off = (size_t)(row0 + ai * HALF + m * 16) * 1024 + col0; float ssq = 0.f;
#pragma unroll
                for (int bj = 0; bj < 2; ++bj)
#pragma unroll
                    for (int n = 0; n < 2; ++n) { f32x4 y = acc[ai][bj][m][n] + *(const f32x4*)(X + off + bj * HALF + n * 16); acc[ai][bj][m][n] = y;
                        ssq += y[0] * y[0] + y[1] * y[1] + y[2] * y[2] + y[3] * y[3]; }
                ssq += __shfl_xor(ssq, 16); ssq += __shfl_xor(ssq, 32);
                if (fq == 0) ls[wc * 256 + ai * HALF + wr * 64 + m * 16 + fr] = ssq; }
        __syncthreads();
        if (tid < 256) {
            const float part = ls[tid] + ls[256 + tid] + ls[512 + tid] + ls[768 + tid];
            const float old = atomicAdd(rowss + u.pm * BM + tid, part);
            asm volatile("" :: "v"(old));
        }
        __syncthreads();
        if (tid == 0) {
            __hip_atomic_fetch_add(cnt + u.pm, 1u, __ATOMIC_RELEASE, __HIP_MEMORY_SCOPE_AGENT);
            while (__hip_atomic_load(cnt + u.pm, __ATOMIC_RELAXED, __HIP_MEMORY_SCOPE_AGENT) < 4u) __builtin_amdgcn_s_sleep(1);
            __builtin_amdgcn_fence(__ATOMIC_ACQUIRE, "agent");
        }
        __syncthreads();
        if (tid < 256) {
            const float tot = __hip_atomic_load(rowss + u.pm * BM + tid, __ATOMIC_RELAXED, __HIP_MEMORY_SCOPE_AGENT);
            ls[1024 + tid] = __builtin_amdgcn_rsqf(tot * (1.f / 1024.f) + 1e-6f);
        }
        __syncthreads();
        f32x4 fw[2][2];
#pragma unroll
        for (int bj = 0; bj < 2; ++bj)
#pragma unroll
            for (int n = 0; n < 2; ++n) fw[bj][n] = *(const f32x4*)(FW + col0 + bj * HALF + n * 16);
#pragma unroll
        for (int ai = 0; ai < 2; ++ai)
#pragma unroll
            for (int m = 0; m < 4; ++m) { const size_t off = (size_t)(row0 + ai * HALF + m * 16) * 1024 + col0;
                const float rs = ls[1024 + ai * HALF + wr * 64 + m * 16 + fr];
#pragma unroll
                for (int bj = 0; bj < 2; ++bj)
#pragma unroll
                    for (int n = 0; n < 2; ++n) *(f32x4*)(C + off + bj * HALF + n * 16) = acc[ai][bj][m][n] * rs * fw[bj][n]; }
        __syncthreads();
    }
};

template <class Epi, class Sched, bool STAMP = false>
__device__ __forceinline__ void gemm_phase(PG8_LAS unsigned char* lds, const Gemm g, const Sched& S, const Epi& E, unsigned long long* stamps) {
    const int tid = threadIdx.x, wid = __builtin_amdgcn_readfirstlane(tid >> 6), lane = tid & 63, wr = wid >> 2, wc = wid & 3, fr = lane & 15, fq = lane >> 4;
    const int K = g.K, nt = K / BK;
    int ts_lo = 0, ts_hi = 0, nts = 0; const unsigned long long rt_entry = STAMP ? (unsigned long long)wall_clock64() : 0ull;
#define PG8_STAMP() do { if (STAMP && wid == 0 && nts < 64) { const unsigned long long _c = (unsigned long long)clock64(); \
        ts_lo = (lane == nts) ? (int)(unsigned)_c : ts_lo; ts_hi = (lane == nts) ? (int)(unsigned)(_c >> 32) : ts_hi; ++nts; } } while (0)
    PG8_STAMP();
    unsigned voffA[2], voffB[2];
#pragma unroll
    for (int i = 0; i < 2; ++i) { int R, C; stage_rc(tid * 16 + i * 8192, R, C); const int Rb = Epi::PERM ? ((R & ~31) + perm32(R & 31)) : R;
        voffA[i] = (unsigned)(R * K + C) * 2u; voffB[i] = (unsigned)(Rb * K + C) * 2u; }
    const size_t kstep = (size_t)(BK * 2);
    const size_t hstep = (size_t)HALF * K * 2;
    const size_t tstep = 2 * hstep;
    const unsigned ldsw = (unsigned)wid * 1024u;
    const int aoff = lds_byte(wr * 64 + fr, fq * 8), boff = lds_byte(wc * 32 + fr, fq * 8);
#define PG8_SA(b, h) (((b) * 2 + (h)) * HTB)
#define PG8_SB(b, h) ((4 + (b) * 2 + (h)) * HTB)
#define PG8_STAGE(bufoff, gbase, voff) do { _Pragma("unroll") for (int _i = 0; _i < 2; ++_i) \
        __builtin_amdgcn_global_load_lds((const unsigned*)((const char*)(gbase) + (voff)[_i]), (PG8_LAS unsigned*)(lds + (bufoff) + ldsw + _i * 8192), 16, 0, 0); } while (0)
#define PG8_LDA(dst, b, h) do { _Pragma("unroll") for (int m = 0; m < 4; ++m) _Pragma("unroll") for (int k = 0; k < 2; ++k) dst[m][k] = *(const PG8_LAS bf16x8*)(lds + PG8_SA(b, h) + aoff + m * 2048 + k * 1024); } while (0)
#define PG8_LDB(dst, b, h) do { _Pragma("unroll") for (int n = 0; n < 2; ++n) _Pragma("unroll") for (int k = 0; k < 2; ++k) dst[n][k] = *(const PG8_LAS bf16x8*)(lds + PG8_SB(b, h) + boff + n * 2048 + k * 1024); } while (0)
#define PG8_MMA(ai, bj, At, Bt) do { __builtin_amdgcn_s_setprio(1); _Pragma("unroll") for (int m = 0; m < 4; ++m) _Pragma("unroll") for (int n = 0; n < 2; ++n) _Pragma("unroll") for (int k = 0; k < 2; ++k) \
        acc[ai][bj][m][n] = __builtin_amdgcn_mfma_f32_16x16x32_bf16(Bt[n][k], At[m][k], acc[ai][bj][m][n], 0, 0, 0); __builtin_amdgcn_s_setprio(0); } while (0)
#define PG8_WAIT_V(n) asm volatile("s_waitcnt vmcnt(" #n ")" ::: "memory")
#define PG8_WAIT_L(n) asm volatile("s_waitcnt lgkmcnt(" #n ")" ::: "memory")
#define PG8_BAR __builtin_amdgcn_s_barrier()
#define PG8_SCHED __builtin_amdgcn_sched_barrier(0)
    Unit cur, nxt; int ui = 0;
    if (!S.next(0, cur)) return;
    f32x4 acc[2][2][4][2];
#pragma unroll
    for (int a = 0; a < 2; ++a)
#pragma unroll
        for (int b = 0; b < 2; ++b)
#pragma unroll
            for (int m = 0; m < 4; ++m)
#pragma unroll
                for (int n = 0; n < 2; ++n) acc[a][b][m][n] = (f32x4){0.f, 0.f, 0.f, 0.f};
    bf16x8 At[4][2], B0[2][2], B1[2][2];
    const char* cA = (const char*)g.A + (size_t)cur.pm * tstep; const char* cB = (const char*)g.Bt + (size_t)cur.pn * tstep;
    S.a_ready(cur);
    PG8_STAGE(PG8_SB(0, 0), cB, voffB); PG8_STAGE(PG8_SA(0, 0), cA, voffA); PG8_STAGE(PG8_SB(0, 1), cB + hstep, voffB); PG8_STAGE(PG8_SA(0, 1), cA + hstep, voffA);
    if (wr == 1) PG8_BAR;
    PG8_WAIT_V(4); PG8_BAR;
    PG8_STAGE(PG8_SB(1, 0), cB + kstep, voffB); PG8_STAGE(PG8_SA(1, 0), cA + kstep, voffA); PG8_STAGE(PG8_SB(1, 1), cB + hstep + kstep, voffB);
    PG8_WAIT_V(6); PG8_BAR;
    PG8_STAMP();
    for (;;) {
        const bool has_next = S.next(ui + 1, nxt);
        const char* nA = has_next ? (const char*)g.A + (size_t)nxt.pm * tstep : cA; const char* nB = has_next ? (const char*)g.Bt + (size_t)nxt.pn * tstep : cB;
        for (int t = 0; t < nt; t += 2) {
            const bool last = (t == nt - 2);
            const char* a1 = cA + (size_t)(t + 1) * kstep;
            const char* a2 = last ? nA : cA + (size_t)(t + 2) * kstep; const char* b2 = last ? nB : cB + (size_t)(t + 2) * kstep;
            const char* a3 = a2 + kstep; const char* b3 = b2 + kstep;
            if (last && has_next) S.a_ready(nxt);
            PG8_LDB(B0, 0, 0); PG8_SCHED; PG8_LDA(At, 0, 0); PG8_STAGE(PG8_SA(1, 1), a1 + hstep, voffA);
            PG8_WAIT_L(8); PG8_BAR; PG8_WAIT_L(0); PG8_MMA(0, 0, At, B0); PG8_BAR; PG8_SCHED;
            PG8_LDB(B1, 0, 1); PG8_STAGE(PG8_SB(0, 0), b2, voffB);
            PG8_BAR; PG8_WAIT_L(0); PG8_MMA(0, 1, At, B1); PG8_BAR;
            PG8_LDA(At, 0, 1); PG8_STAGE(PG8_SA(0, 0), a2, voffA);
            PG8_BAR; PG8_WAIT_L(0); PG8_MMA(1, 0, At, B0); PG8_BAR; PG8_SCHED;
            PG8_STAGE(PG8_SB(0, 1), b2 + hstep, voffB);
            PG8_WAIT_V(6); PG8_BAR; PG8_MMA(1, 1, At, B1); PG8_BAR;
            PG8_LDB(B0, 1, 0); PG8_SCHED; PG8_LDA(At, 1, 0); PG8_STAGE(PG8_SA(0, 1), a2 + hstep, voffA);
            PG8_WAIT_L(8); PG8_BAR; PG8_WAIT_L(0); PG8_MMA(0, 0, At, B0); PG8_BAR; PG8_SCHED;
            PG8_LDB(B1, 1, 1); PG8_STAGE(PG8_SB(1, 0), b3, voffB);
            PG8_BAR; PG8_WAIT_L(0); PG8_MMA(0, 1, At, B1); PG8_BAR;
            PG8_LDA(At, 1, 1); PG8_STAGE(PG8_SA(1, 0), a3, voffA);
            PG8_BAR; PG8_WAIT_L(0); PG8_MMA(1, 0, At, B0); PG8_BAR; PG8_SCHED;
            PG8_STAGE(PG8_SB(1, 1), b3 + hstep, voffB);
            PG8_WAIT_V(6); PG8_BAR; PG8_MMA(1, 1, At, B1); PG8_BAR;
        }
        PG8_STAMP();
        if constexpr (!Epi::AFTER_DRAIN) { E(acc, cur, wr, wc, fr, fq); S.done(cur); }
        PG8_STAMP();
        if (!has_next) break;
#pragma unroll
        for (int a = 0; a < 2; ++a)
#pragma unroll
            for (int b = 0; b < 2; ++b)
#pragma unroll
                for (int m = 0; m < 4; ++m)
#pragma unroll
                    for (int n = 0; n < 2; ++n) acc[a][b][m][n] = (f32x4){0.f, 0.f, 0.f, 0.f};
        cur = nxt; cA = nA; cB = nB; ++ui;
    }
    PG8_WAIT_V(0);
    if (wr == 0) PG8_BAR;
    PG8_BAR;
    if constexpr (Epi::AFTER_DRAIN) { E.fused(acc, cur, wr, wc, fr, fq, lds, wid, lane); S.done(cur); }
    PG8_STAMP();
    if (STAMP && wid == 0) { stamps[lane] = lane < nts ? (((unsigned long long)(unsigned)ts_hi << 32) | (unsigned)ts_lo) : 0ull;
        if (lane == 62) stamps[62] = rt_entry; if (lane == 63) stamps[63] = (unsigned long long)wall_clock64(); }
#undef PG8_STAMP
#undef PG8_SA
#undef PG8_SB
#undef PG8_STAGE
#undef PG8_LDA
#undef PG8_LDB
#undef PG8_MMA
#undef PG8_WAIT_V
#undef PG8_WAIT_L
#undef PG8_BAR
#undef PG8_SCHED
}
}

#define GLD 72
template <int EPI>
__device__ void gemm_tile(const Params& p, const bf16_t* __restrict__ A, const bf16_t* __restrict__ Bt,
                          const int K, const int m0, const int n0, char* smem) {
  bf16_t* As = (bf16_t*)smem;
  bf16_t* Bs = As + 256 * GLD;
  const int tid = threadIdx.x, lane = tid & 63, wid = tid >> 6;
  const int r = lane & 31, hh = lane >> 5;
  const int wm = wid >> 1, wn = wid & 1;
  f32x16 acc[2][2];
#pragma unroll
  for (int i = 0; i < 2; i++)
#pragma unroll
    for (int j = 0; j < 2; j++)
#pragma unroll
      for (int e = 0; e < 16; e++) acc[i][j][e] = 0.f;
  uint4 ra0, ra1, ra2, ra3, rb0, rb1;
  const int lrow = tid >> 3, lc = (tid & 7) * 8;
  const bf16_t* Ap = A + (size_t)(m0 + lrow) * K + lc;
  const bf16_t* Bp = Bt + (size_t)(n0 + lrow) * K + lc;
#define GLOAD(kt)                                                   \
  ra0 = *(const uint4*)(Ap + (size_t)(kt) * 64);                    \
  ra1 = *(const uint4*)(Ap + (size_t)64 * K + (size_t)(kt) * 64);   \
  ra2 = *(const uint4*)(Ap + (size_t)128 * K + (size_t)(kt) * 64);  \
  ra3 = *(const uint4*)(Ap + (size_t)192 * K + (size_t)(kt) * 64);  \
  rb0 = *(const uint4*)(Bp + (size_t)(kt) * 64);                    \
  rb1 = *(const uint4*)(Bp + (size_t)64 * K + (size_t)(kt) * 64);
  const int nk = K / 64;
  GLOAD(0);
  for (int kt = 0; kt < nk; kt++) {
    __syncthreads();
    *(uint4*)(As + (lrow) * GLD + lc) = ra0;
    *(uint4*)(As + (lrow + 64) * GLD + lc) = ra1;
    *(uint4*)(As + (lrow + 128) * GLD + lc) = ra2;
    *(uint4*)(As + (lrow + 192) * GLD + lc) = ra3;
    *(uint4*)(Bs + (lrow) * GLD + lc) = rb0;
    *(uint4*)(Bs + (lrow + 64) * GLD + lc) = rb1;
    __syncthreads();
    if (kt + 1 < nk) { GLOAD(kt + 1); }
#pragma unroll
    for (int s = 0; s < 4; s++) {
      bf16x8 a[2], b[2];
#pragma unroll
      for (int i = 0; i < 2; i++) a[i] = *(const bf16x8*)(As + (wm * 64 + i * 32 + r) * GLD + s * 16 + hh * 8);
#pragma unroll
      for (int j = 0; j < 2; j++) b[j] = *(const bf16x8*)(Bs + (wn * 64 + j * 32 + r) * GLD + s * 16 + hh * 8);
#pragma unroll
      for (int i = 0; i < 2; i++)
#pragma unroll
        for (int j = 0; j < 2; j++)
          acc[i][j] = __builtin_amdgcn_mfma_f32_32x32x16_bf16(a[i], b[j], acc[i][j], 0, 0, 0);
    }
  }
  const float sc = (EPI == 0 && n0 < 512) ? QSCALE : 1.f;
#pragma unroll
  for (int i = 0; i < 2; i++)
#pragma unroll
    for (int j = 0; j < 2; j++)
#pragma unroll
      for (int e = 0; e < 16; e++) {
        const int m = m0 + wm * 64 + i * 32 + (e & 3) + 8 * (e >> 2) + 4 * hh;
        const int n = n0 + wn * 64 + j * 32 + r;
        if (EPI == 0) {
          p.proj[(size_t)m * NPROJ + n] = f2bf(acc[i][j][e] * sc);
        } else {
          p.out[(size_t)m * D_MODEL + n] = p.x[(size_t)m * D_MODEL + n] + acc[i][j][e];
        }
      }
}

#define PLD 132
#define ALD 68
typedef float f32x2 __attribute__((ext_vector_type(2)));
__device__ __forceinline__ void conv_item(const uint4 (&xr)[7], const float4 (&wlo)[4], const float4 (&whi)[4],
                                          float* dstp, const int i0, float (&ss)[4]) {
#pragma unroll
  for (int i = 0; i < 4; i++) {
    float o[8];
#pragma unroll
    for (int c = 0; c < 8; c++) o[c] = 0.f;
#pragma unroll
    for (int tap = 0; tap < 4; tap++) {
      const uint4 xv = xr[i + tap];
      const unsigned xw[4] = {xv.x, xv.y, xv.z, xv.w};
      const float wv[8] = {wlo[tap].x, wlo[tap].y, wlo[tap].z, wlo[tap].w, whi[tap].x, whi[tap].y, whi[tap].z, whi[tap].w};
#pragma unroll
      for (int c2 = 0; c2 < 4; c2++) {
        o[2 * c2] += wv[2 * c2] * __uint_as_float(xw[c2] << 16);
        o[2 * c2 + 1] += wv[2 * c2 + 1] * __uint_as_float(xw[c2] & 0xffff0000u);
      }
    }
    float sq = 0.f;
#pragma unroll
    for (int c = 0; c < 8; c++) { o[c] = silu_f(o[c]); sq += o[c] * o[c]; }
    ss[i] = sq;
    *(float4*)(dstp + (i0 + i) * PLD) = make_float4(o[0], o[1], o[2], o[3]);
    *(float4*)(dstp + (i0 + i) * PLD + 4) = make_float4(o[4], o[5], o[6], o[7]);
  }
}

__device__ void gdn_prep(const Params& p, const int task, char* smem, const int mode = 3, const int foff = 0) {
  float* qs = (float*)smem;
  float* ks = qs + 64 * PLD;
  float* vs = ks + 64 * PLD;
  float* Am = vs + 64 * PLD;
  float* gs = Am + 64 * ALD;
  float* bs = gs + 64;
  float* rq = bs + 64;
  float* rk = rq + 64;
  float* su = rk + 64;
  float* sw = su + 64;
  float* qfac = sw + 64;
  float* kfac = qfac + 64;
  int tid = threadIdx.x;
  asm volatile("" : "+v"(tid));
  const int lane = tid & 63, wid = tid >> 6;
  const int bh = task >> 5, chunk = task & 31, b = bh >> 2, hd = bh & 3;
  const int t0 = chunk * 64;
  const size_t row0 = (size_t)b * T_SEQ + t0;
  __syncthreads();
  {
    float braw = 0.f, araw = 0.f;
    if (wid == 7) { braw = p.gba[(row0 + lane) * 8 + hd]; araw = p.gba[(row0 + lane) * 8 + 4 + hd]; }
    const int itemA = tid, itemB = tid + NTHREADS;
    const int cgA = itemA % 48, segA = itemA / 48, cgB = itemB % 48, segB = itemB / 48;
    const int whA = cgA >> 4, whB = cgB >> 4;
    const int ccA = whA * 512 + hd * 128 + (cgA & 15) * 8, ccB = whB * 512 + hd * 128 + (cgB & 15) * 8;
    const bool hasB = tid < 256;
    uint4 xa[7], xb[7];
    float4 wla[4], wha[4];
    {
      const bf16_t* pa = p.proj + ((size_t)b * T_SEQ) * NPROJ + 2048 + ccA;
      const int ta = t0 + segA * 4 - 3;
#pragma unroll
      for (int j = 0; j < 7; j++) {
        const int tt = ta + j;
        const uint4 v = *(const uint4*)(pa + (size_t)(tt < 0 ? 0 : tt) * NPROJ);
        xa[j] = make_uint4(tt < 0 ? 0u : v.x, tt < 0 ? 0u : v.y, tt < 0 ? 0u : v.z, tt < 0 ? 0u : v.w);
      }
    }
    if (hasB) {
      const bf16_t* pb = p.proj + ((size_t)b * T_SEQ) * NPROJ + 2048 + ccB;
      const int tb = t0 + segB * 4 - 3;
#pragma unroll
      for (int j = 0; j < 7; j++) {
        const int tt = tb + j;
        const uint4 v = *(const uint4*)(pb + (size_t)(tt < 0 ? 0 : tt) * NPROJ);
        xb[j] = make_uint4(tt < 0 ? 0u : v.x, tt < 0 ? 0u : v.y, tt < 0 ? 0u : v.z, tt < 0 ? 0u : v.w);
      }
    }
#pragma unroll
    for (int tap = 0; tap < 4; tap++) {
      wla[tap] = *(const float4*)(p.conv_w + tap * 1536 + ccA);
      wha[tap] = *(const float4*)(p.conv_w + tap * 1536 + ccA + 4);
    }
    float ss[4];
    conv_item(xa, wla, wha, (whA == 0 ? qs : (whA == 1 ? ks : vs)) + (cgA & 15) * 8, segA * 4, ss);
    if (whA < 2) {
#pragma unroll
      for (int i = 0; i < 4; i++) {
        float v = ss[i];
        v = row16_sum(v);
        if ((lane & 15) == 0) (whA == 0 ? rq : rk)[segA * 4 + i] = v;
      }
    }
    if (hasB) {
      __builtin_amdgcn_sched_barrier(0);
#pragma unroll
      for (int tap = 0; tap < 4; tap++) {
        wla[tap] = *(const float4*)(p.conv_w + tap * 1536 + ccB);
        wha[tap] = *(const float4*)(p.conv_w + tap * 1536 + ccB + 4);
      }
      conv_item(xb, wla, wha, (whB == 0 ? qs : (whB == 1 ? ks : vs)) + (cgB & 15) * 8, segB * 4, ss);
      if (whB < 2) {
#pragma unroll
        for (int i = 0; i < 4; i++) {
          float v = ss[i];
          v = row16_sum(v);
          if ((lane & 15) == 0) (whB == 0 ? rq : rk)[segB * 4 + i] = v;
        }
      }
    }
    if (wid == 7) {
      const float beta = __builtin_amdgcn_rcpf(1.f + __expf(-braw));
      const float xx = araw + p.dt_bias[hd];
      const float sp = fmaxf(xx, 0.f) + log1pf(__expf(-fabsf(xx)));
      float g = -__expf(p.A_log[hd]) * sp;
      g += dpp_mov<0x111>(g);
      g += dpp_mov<0x112>(g);
      g += dpp_mov<0x114>(g);
      g += dpp_mov<0x118>(g);
      {
        const float t0_ = __shfl(g, 15), t1_ = __shfl(g, 31), t2_ = __shfl(g, 47);
        const int row_ = lane >> 4;
        g += (row_ > 0 ? t0_ : 0.f) + (row_ > 1 ? t1_ : 0.f) + (row_ > 2 ? t2_ : 0.f);
      }
      gs[lane] = g; bs[lane] = beta;
      if (lane == 63) st_wt_b32(p.eglast + task, __float_as_uint(__expf(g)));
    }
  }
  __syncthreads();
  if (tid < 64) {
    const float rqi = rsqrtf(rq[tid] + EPS) * 0.08838834764831845f;
    rq[tid] = rqi; qfac[tid] = rqi * __expf(gs[tid]);
  } else if (tid < 128) {
    const int i = tid - 64;
    const float rki = rsqrtf(rk[i] + EPS);
    rk[i] = rki; su[i] = bs[i]; sw[i] = bs[i] * __expf(gs[i]) * rki;
    kfac[i] = rki * __expf(gs[63] - gs[i]);
  }
  __syncthreads();
  if (mode == 1) return;
  {
    const int r = lane & 31, hh = lane >> 5;
    if (wid < 3) {
      const int ti = wid == 0 ? 0 : 1, tj = wid == 2 ? 1 : 0;
      f32x16 acc;
#pragma unroll
      for (int e = 0; e < 16; e++) acc[e] = 0.f;
#pragma unroll 4
      for (int s = 0; s < 16; s++) {
        const float4 xa = *(const float4*)(ks + (ti * 32 + r) * PLD + 8 * s + 4 * hh);
        const float4 yb = *(const float4*)(ks + (tj * 32 + r) * PLD + 8 * s + 4 * hh);
        acc = __builtin_amdgcn_mfma_f32_32x32x2f32(xa.x, yb.x, acc, 0, 0, 0);
        acc = __builtin_amdgcn_mfma_f32_32x32x2f32(xa.y, yb.y, acc, 0, 0, 0);
        acc = __builtin_amdgcn_mfma_f32_32x32x2f32(xa.z, yb.z, acc, 0, 0, 0);
        acc = __builtin_amdgcn_mfma_f32_32x32x2f32(xa.w, yb.w, acc, 0, 0, 0);
      }
      const int j = tj * 32 + r;
      const float gj = gs[j], rkj = rk[j];
#pragma unroll
      for (int e = 0; e < 16; e++) {
        const int i = ti * 32 + (e & 3) + 8 * (e >> 2) + 4 * hh;
        const float val = acc[e] * rkj * rk[i] * __expf(fminf(gs[i] - gj, 0.f));
        Am[j * ALD + i] = (j < i) ? val * bs[i] : 0.f;
      }
    } else if (wid == 3 || wid == 4) {
      const int ts0 = wid == 3 ? 0 : 2, ts1 = wid == 3 ? 2 : 3;
#pragma unroll 1
      for (int tsel = ts0; tsel < ts1; tsel++) {
        const int ti = tsel == 0 ? 0 : 1, tj = tsel == 2 ? 1 : 0;
        f32x16 acc;
#pragma unroll
        for (int e2 = 0; e2 < 16; e2++) acc[e2] = 0.f;
#pragma unroll 4
        for (int s2 = 0; s2 < 8; s2++) {
          const float* qp = qs + (ti * 32 + r) * PLD + 16 * s2 + 8 * hh;
          const float* kp = ks + (tj * 32 + r) * PLD + 16 * s2 + 8 * hh;
          const float4 q0 = *(const float4*)qp, q1 = *(const float4*)(qp + 4);
          const float4 k0 = *(const float4*)kp, k1 = *(const float4*)(kp + 4);
          union { unsigned u[4]; bf16x8 v; } fa, fb;
          fa.u[0] = cvt_pk_bf16(q0.x, q0.y); fa.u[1] = cvt_pk_bf16(q0.z, q0.w); fa.u[2] = cvt_pk_bf16(q1.x, q1.y); fa.u[3] = cvt_pk_bf16(q1.z, q1.w);
          fb.u[0] = cvt_pk_bf16(k0.x, k0.y); fb.u[1] = cvt_pk_bf16(k0.z, k0.w); fb.u[2] = cvt_pk_bf16(k1.x, k1.y); fb.u[3] = cvt_pk_bf16(k1.z, k1.w);
          acc = __builtin_amdgcn_mfma_f32_32x32x16_bf16(fa.v, fb.v, acc, 0, 0, 0);
        }
        const int j = tj * 32 + r;
        const float gj = gs[j], rkj = rk[j];
#pragma unroll
        for (int e2 = 0; e2 < 16; e2++) {
          const int i = ti * 32 + (e2 & 3) + 8 * (e2 >> 2) + 4 * hh;
          const float val = acc[e2] * rkj * rq[i] * __expf(fminf(gs[i] - gj, 0.f));
          st_wt_b16(p.AI + (size_t)task * 4096 + i * 64 + j, (unsigned)f2bf((j <= i) ? val : 0.f));
        }
      }
      if (wid == 4) {
#pragma unroll
        for (int e2 = 0; e2 < 16; e2++) {
          const int i = (e2 & 3) + 8 * (e2 >> 2) + 4 * hh;
          st_wt_b16(p.AI + (size_t)task * 4096 + i * 64 + 32 + r, 0u);
        }
      }
    } else {
      const int t2 = tid - 320;
#pragma unroll 2
      for (int v = t2; v < 1024; v += 192) {
        const int i = v >> 4, d0 = (v & 15) * 8;
        const float sc = qfac[i];
        const float4 a0 = *(const float4*)(qs + i * PLD + d0), a1 = *(const float4*)(qs + i * PLD + d0 + 4);
        st_wt_b128(p.QG + ((size_t)bh * T_SEQ + t0 + i) * 128 + d0,
                   cvt_pk_bf16(a0.x * sc, a0.y * sc), cvt_pk_bf16(a0.z * sc, a0.w * sc),
                   cvt_pk_bf16(a1.x * sc, a1.y * sc), cvt_pk_bf16(a1.z * sc, a1.w * sc));
      }
#pragma unroll 2
      for (int v = t2; v < 1024; v += 192) {
        const int d = v & 127, i0 = (v >> 7) * 8;
        float kv[8], kf[8];
#pragma unroll
        for (int e2 = 0; e2 < 8; e2++) { kv[e2] = ks[(i0 + e2) * PLD + d]; kf[e2] = kfac[i0 + e2]; }
#pragma unroll
        for (int e2 = 0; e2 < 8; e2++) kv[e2] *= kf[e2];
        st_wt_b128(p.KDt + (size_t)task * 8192 + d * 64 + i0,
                   cvt_pk_bf16(kv[0], kv[1]), cvt_pk_bf16(kv[2], kv[3]), cvt_pk_bf16(kv[4], kv[5]), cvt_pk_bf16(kv[6], kv[7]));
      }
    }
  }
  __syncthreads();
  if (mode == 2) return;
  {
    const int c = tid & 255;
    float* colp = c < 128 ? (vs + c) : (ks + (c - 128));
    const float* scl = c < 128 ? su : sw;
    bf16_t* dstW = p.W + ((size_t)bh * T_SEQ + t0) * 128 + (c & 127);
    bf16_t* dstU = p.U + (size_t)task * 8192 + (size_t)(c & 127) * 64;
#pragma unroll 1
    for (int half = 0; half < 2; half++) {
      if (tid < 256) {
#pragma unroll 1
        for (int blk = 0; blk < 2; blk++) {
          const int rb = half * 32 + blk * 16;
          float* cp = colp + rb * PLD;
          f32x2 acc[8];
          {
            float rv[16], sv[16];
#pragma unroll
            for (int ii = 0; ii < 16; ii++) { rv[ii] = cp[ii * PLD]; sv[ii] = scl[rb + ii]; }
#pragma unroll
            for (int ii = 0; ii < 16; ii++) acc[ii >> 1][ii & 1] = half == 0 ? rv[ii] * sv[ii] : rv[ii];
          }
          if (blk == 1) {
#pragma unroll 1
            for (int j0 = 0; j0 < 16; j0 += 4) {
              float xj[4];
              f32x2 av[4][8];
#pragma unroll
              for (int jj = 0; jj < 4; jj++) {
                xj[jj] = colp[(half * 32 + j0 + jj) * PLD];
                const f32x2* ap = (const f32x2*)(Am + (half * 32 + j0 + jj) * ALD + rb);
#pragma unroll
                for (int k2 = 0; k2 < 8; k2++) av[jj][k2] = ap[k2];
              }
              __builtin_amdgcn_sched_barrier(0);
#pragma unroll
              for (int jj = 0; jj < 4; jj++) {
                const f32x2 x2 = {xj[jj], xj[jj]};
#pragma unroll
                for (int k2 = 0; k2 < 8; k2++) acc[k2] -= av[jj][k2] * x2;
              }
            }
          }
          {
            float as1[8];
            f32x2 ap2[15][8];
#pragma unroll
            for (int jj = 0; jj < 15; jj++) {
              const float* arow = Am + (rb + jj) * ALD + rb;
              if ((jj & 1) == 0) as1[jj >> 1] = arow[jj + 1];
#pragma unroll
              for (int k2 = (jj >> 1) + 1; k2 < 8; k2++) ap2[jj][k2] = *(const f32x2*)(arow + 2 * k2);
            }
            __builtin_amdgcn_sched_barrier(0);
#pragma unroll
            for (int jj = 0; jj < 15; jj++) {
              const float xj = acc[jj >> 1][jj & 1];
              if ((jj & 1) == 0) acc[jj >> 1][1] -= as1[jj >> 1] * xj;
              const f32x2 x2 = {xj, xj};
#pragma unroll
              for (int k2 = (jj >> 1) + 1; k2 < 8; k2++) acc[k2] -= ap2[jj][k2] * x2;
            }
          }
#pragma unroll
          for (int ii = 0; ii < 16; ii++) cp[ii * PLD] = acc[ii >> 1][ii & 1];
          if (c < 128) {
            st_wt_b128(dstU + rb, cvt_pk_bf16(acc[0][0], acc[0][1]), cvt_pk_bf16(acc[1][0], acc[1][1]),
                       cvt_pk_bf16(acc[2][0], acc[2][1]), cvt_pk_bf16(acc[3][0], acc[3][1]));
            st_wt_b128(dstU + rb + 8, cvt_pk_bf16(acc[4][0], acc[4][1]), cvt_pk_bf16(acc[5][0], acc[5][1]),
                       cvt_pk_bf16(acc[6][0], acc[6][1]), cvt_pk_bf16(acc[7][0], acc[7][1]));
          } else {
#pragma unroll
            for (int ii = 0; ii < 16; ii++) st_wt_b16(dstW + (size_t)(rb + ii) * 128, (unsigned)f2bf(acc[ii >> 1][ii & 1]));
          }
        }
      }
      if (half == 0) {
        __syncthreads();
        const int r = lane & 31, hh = lane >> 5;
        float* arr = (wid < 4 ? vs : ks) + (wid & 3) * 32 + r;
        const float* sc2 = wid < 4 ? su : sw;
        f32x16 cacc;
#pragma unroll
        for (int e = 0; e < 16; e++) {
          const int i = 32 + (e & 3) + 8 * (e >> 2) + 4 * hh;
          cacc[e] = arr[i * PLD] * sc2[i];
        }
        {
          float av[16], bv[16];
#pragma unroll
          for (int k0 = 0; k0 < 16; k0++) { av[k0] = -Am[(2 * k0 + hh) * ALD + 32 + r]; bv[k0] = arr[(2 * k0 + hh) * PLD]; }
          __builtin_amdgcn_sched_barrier(0);
#pragma unroll
          for (int k0 = 0; k0 < 16; k0++) cacc = __builtin_amdgcn_mfma_f32_32x32x2f32(av[k0], bv[k0], cacc, 0, 0, 0);
        }
#pragma unroll
        for (int e = 0; e < 16; e++) {
          const int i = 32 + (e & 3) + 8 * (e >> 2) + 4 * hh;
          arr[i * PLD] = cacc[e];
        }
        __syncthreads();
      }
    }
  }
  asm volatile("s_waitcnt vmcnt(0)" ::: "memory");
  __syncthreads();
  if (tid == 0) __hip_atomic_store(&p.flags[foff + task], 1u, __ATOMIC_RELAXED, __HIP_MEMORY_SCOPE_AGENT);
}

#define SLD 136
#define VLD 72
__device__ void gdn_scan(const Params& p, const int bh, char* smem, const int mode = 0, const int foff = 0) {
  bf16_t* St = (bf16_t*)smem;
  bf16_t* vT = St + 128 * SLD;
  bf16_t* wsm = vT + 128 * VLD;
  bf16_t* qgs = wsm + 64 * SLD;
  bf16_t* kdTs = qgs + 64 * SLD;
  bf16_t* AIs = kdTs + 128 * VLD;
  bf16_t* wsm_A = wsm; bf16_t* qgs_A = qgs;
  bf16_t* wsm_B = AIs + 64 * VLD;
  bf16_t* qgs_B = wsm_B + 64 * SLD;
  float* obuf = (float*)wsm;
  float* nws = (float*)(smem + 120 * 1024);
  int tid = threadIdx.x;
  asm volatile("" : "+v"(tid));
  const int lane = tid & 63, wid = tid >> 6;
  const int r = lane & 31, hh = lane >> 5;
  const int mi = wid & 1, ni = wid >> 1;
  const int b = bh >> 2, hd = bh & 3;
  f32x16 accS[2];
#pragma unroll
  for (int q = 0; q < 2; q++)
#pragma unroll
    for (int e = 0; e < 16; e++) accS[q][e] = 0.f;
  __syncthreads();
  for (int idx = tid; idx < 128 * SLD / 2; idx += NTHREADS) ((unsigned*)St)[idx] = 0u;
  const int srow = tid >> 4, sc16 = (tid & 15) * 8;
  const int krow = tid >> 3, kc8 = (tid & 7) * 8;
  const int ntok = wid * 8 + (lane >> 4), nd0 = (lane & 15) * 8;
  uint4 pw0A, pw1A, pq0A, pq1A, pw0B, pw1B, pq0B, pq1B, pk0, pk1, pa0;
  uint2 un0A, un1A, un2A, un3A, un0B, un1B, un2B, un3B;
  float egk;
#define SCAN_LOAD(nn, S)                                                                      \
  {                                                                                           \
    const int task_ = bh * 32 + (nn);                                                         \
    const size_t trow_ = (size_t)bh * T_SEQ + (nn) * 64;                                      \
    pw0##S = *(const uint4*)(p.W + (trow_ + srow) * 128 + sc16);                              \
    pw1##S = *(const uint4*)(p.W + (trow_ + srow + 32) * 128 + sc16);                         \
    pq0##S = *(const uint4*)(p.QG + (trow_ + srow) * 128 + sc16);                             \
    pq1##S = *(const uint4*)(p.QG + (trow_ + srow + 32) * 128 + sc16);                        \
  }
#define SCAN_LOAD_U(nn, S)                                                                    \
  {                                                                                           \
    const bf16_t* up_ = p.U + (size_t)(bh * 32 + (nn)) * 8192 + (ni * 32 + r) * 64 + mi * 32 + 4 * hh; \
    un0##S = *(const uint2*)(up_); un1##S = *(const uint2*)(up_ + 8);                         \
    un2##S = *(const uint2*)(up_ + 16); un3##S = *(const uint2*)(up_ + 24);                   \
  }
#define SCAN_LOAD_K(nn)                                                                        \
  {                                                                                           \
    const int task_ = bh * 32 + (nn);                                                         \
    pk0 = *(const uint4*)(p.KDt + (size_t)task_ * 8192 + krow * 64 + kc8);                    \
    pk1 = *(const uint4*)(p.KDt + (size_t)task_ * 8192 + (krow + 64) * 64 + kc8);             \
    pa0 = *(const uint4*)(p.AI + (size_t)task_ * 4096 + krow * 64 + kc8);                     \
    egk = p.eglast[task_];                                                                    \
  }
#define SCAN_POLL(ff, tk)                                                                          \
  while ((ff) == 0u) {                                                                             \
    __builtin_amdgcn_s_sleep(2);                                                                   \
    (ff) = __hip_atomic_load(&p.flags[foff + (tk)], __ATOMIC_RELAXED, __HIP_MEMORY_SCOPE_AGENT);  \
  }
#define SCAN_STEP(n, S, T) \
  { \
    const bool pollstep = tid == 0 && mode == 0 && (n & 3) == 0 && n + 3 < 32; \
    __syncthreads(); \
    *(uint4*)(kdTs + krow * VLD + kc8) = pk0; \
    *(uint4*)(kdTs + (krow + 64) * VLD + kc8) = pk1; \
    *(uint4*)(AIs + krow * VLD + kc8) = pa0; \
    const float eg = egk; \
    const size_t grow0 = (size_t)b * T_SEQ + n * 64; \
    __builtin_amdgcn_sched_barrier(0); \
    if (n + 1 < 32 && mode != 1) SCAN_LOAD_K(n + 1); if (n + 2 < 32 && mode != 1) SCAN_LOAD(n + 2, S); \
    __builtin_amdgcn_sched_barrier(0); \
    f32x16 accv, acco; \
    _Pragma("unroll") \
    for (int e = 0; e < 16; e++) { accv[e] = 0.f; acco[e] = 0.f; } \
    _Pragma("unroll 4") \
    for (int s = 0; s < 8; s++) { \
      const bf16x8 bS = *(const bf16x8*)(St + (ni * 32 + r) * SLD + s * 16 + hh * 8); \
      const bf16x8 aW = *(const bf16x8*)(wsm_##S + (mi * 32 + r) * SLD + s * 16 + hh * 8); \
      const bf16x8 aQ = *(const bf16x8*)(qgs_##S + (mi * 32 + r) * SLD + s * 16 + hh * 8); \
      accv = __builtin_amdgcn_mfma_f32_32x32x16_bf16(aW, bS, accv, 0, 0, 0); \
      acco = __builtin_amdgcn_mfma_f32_32x32x16_bf16(aQ, bS, acco, 0, 0, 0); \
    } \
    _Pragma("unroll") \
    for (int g = 0; g < 4; g++) { \
      const uint2 uu_ = g == 0 ? un0##S : (g == 1 ? un1##S : (g == 2 ? un2##S : un3##S)); \
      const float v0_ = __uint_as_float(uu_.x << 16) - accv[4 * g], v1_ = __uint_as_float(uu_.x & 0xffff0000u) - accv[4 * g + 1]; \
      const float v2_ = __uint_as_float(uu_.y << 16) - accv[4 * g + 2], v3_ = __uint_as_float(uu_.y & 0xffff0000u) - accv[4 * g + 3]; \
      *(uint2*)(vT + (ni * 32 + r) * VLD + mi * 32 + 8 * g + 4 * hh) = make_uint2(cvt_pk_bf16(v0_, v1_), cvt_pk_bf16(v2_, v3_)); \
    } \
    if (n + 2 < 32 && mode != 1) SCAN_LOAD_U(n + 2, S); \
    __syncthreads(); \
    _Pragma("unroll") \
    for (int q = 0; q < 2; q++) \
    _Pragma("unroll") \
      for (int e = 0; e < 16; e++) accS[q][e] *= eg; \
    _Pragma("unroll") \
    for (int s = 0; s < 4; s++) { \
      const bf16x8 bV = *(const bf16x8*)(vT + (ni * 32 + r) * VLD + s * 16 + hh * 8); \
      const bf16x8 aA = *(const bf16x8*)(AIs + (mi * 32 + r) * VLD + s * 16 + hh * 8); \
      const bf16x8 aK0 = *(const bf16x8*)(kdTs + ((2 * mi) * 32 + r) * VLD + s * 16 + hh * 8); \
      const bf16x8 aK1 = *(const bf16x8*)(kdTs + ((2 * mi + 1) * 32 + r) * VLD + s * 16 + hh * 8); \
      accS[0] = __builtin_amdgcn_mfma_f32_32x32x16_bf16(aK0, bV, accS[0], 0, 0, 0); \
      accS[1] = __builtin_amdgcn_mfma_f32_32x32x16_bf16(aK1, bV, accS[1], 0, 0, 0); \
      acco = __builtin_amdgcn_mfma_f32_32x32x16_bf16(aA, bV, acco, 0, 0, 0); \
    } \
    _Pragma("unroll") \
    for (int q = 0; q < 2; q++) { \
      const int dkb = 2 * mi + q; \
    _Pragma("unroll") \
      for (int g = 0; g < 4; g++) \
        *(uint2*)(St + (ni * 32 + r) * SLD + dkb * 32 + 8 * g + 4 * hh) = \
            make_uint2(cvt_pk_bf16(accS[q][4 * g], accS[q][4 * g + 1]), cvt_pk_bf16(accS[q][4 * g + 2], accS[q][4 * g + 3])); \
    } \
    { \
      bf16_t* ob = (mode ? p.W : p.U) + (size_t)(bh * 32 + n) * 8192 + ni * 32 + r; \
    _Pragma("unroll") \
      for (int e = 0; e < 16; e++) { \
        const int tok = mi * 32 + (e & 3) + 8 * (e >> 2) + 4 * hh; \
        ob[tok * 128] = f2bf(acco[e]); \
      } \
    } \
    if (n + 1 < 32) { \
      *(uint4*)(wsm_##T + srow * SLD + sc16) = pw0##T; \
      *(uint4*)(wsm_##T + (srow + 32) * SLD + sc16) = pw1##T; \
      *(uint4*)(qgs_##T + srow * SLD + sc16) = pq0##T; \
      *(uint4*)(qgs_##T + (srow + 32) * SLD + sc16) = pq1##T; \
    } \
    if (pollstep) { \
      _Pragma("unroll") for (int c_ = 3; c_ < 7; c_++) { \
        if (n + c_ < 32) { unsigned f_ = 0u; SCAN_POLL(f_, bh * 32 + n + c_); } \
      } \
      __builtin_amdgcn_fence(__ATOMIC_ACQUIRE, "agent"); \
      asm volatile("s_waitcnt vmcnt(0)" ::: "memory"); \
    } \
  }
  if (mode == 0) {
    if (tid == 0) {
      unsigned f0 = 0u, f1 = 0u, f2 = 0u;
      SCAN_POLL(f0, bh * 32);
      SCAN_POLL(f1, bh * 32 + 1);
      SCAN_POLL(f2, bh * 32 + 2);
      __builtin_amdgcn_fence(__ATOMIC_ACQUIRE, "agent");
      asm volatile("s_waitcnt vmcnt(0)" ::: "memory");
    }
    __syncthreads();
  }
  SCAN_LOAD(0, A);
  SCAN_LOAD_U(0, A);
  SCAN_LOAD_K(0);
  *(uint4*)(wsm_A + srow * SLD + sc16) = pw0A;
  *(uint4*)(wsm_A + (srow + 32) * SLD + sc16) = pw1A;
  *(uint4*)(qgs_A + srow * SLD + sc16) = pq0A;
  *(uint4*)(qgs_A + (srow + 32) * SLD + sc16) = pq1A;
  SCAN_LOAD(1, B);
  SCAN_LOAD_U(1, B);
#pragma unroll 1
  for (int n2 = 0; n2 < 32; n2 += 2) {
    { const int n = n2; SCAN_STEP(n, A, B) }
    { const int n = n2 + 1; SCAN_STEP(n, B, A) }
  }
#undef SCAN_POLL
#undef SCAN_STEP
#undef SCAN_LOAD_U
#undef SCAN_LOAD_K
#undef SCAN_LOAD
}

__device__ void gdn_normgate(const Params& p, const int task) {
  const int tid = threadIdx.x;
  const int bh = task >> 5, chunk = task & 31, b = bh >> 2, hd = bh & 3;
  const int d0 = (tid & 15) * 8;
  const size_t grow0 = (size_t)b * T_SEQ + chunk * 64;
  const float4 nw0 = *(const float4*)(p.gdn_norm_w + d0), nw1 = *(const float4*)(p.gdn_norm_w + d0 + 4);
  const float nwv[8] = {nw0.x, nw0.y, nw0.z, nw0.w, nw1.x, nw1.y, nw1.z, nw1.w};
  uint4 ov[2], gz[2];
#pragma unroll
  for (int ps = 0; ps < 2; ps++) {
    const int tok = (tid >> 4) + 32 * ps;
    ov[ps] = *(const uint4*)(p.U + (size_t)task * 8192 + tok * 128 + d0);
    gz[ps] = *(const uint4*)(p.proj + (grow0 + tok) * NPROJ + 3584 + hd * 128 + d0);
  }
#pragma unroll
  for (int ps = 0; ps < 2; ps++) {
    const int tok = (tid >> 4) + 32 * ps;
    const unsigned ow_[4] = {ov[ps].x, ov[ps].y, ov[ps].z, ov[ps].w};
    const unsigned gw[4] = {gz[ps].x, gz[ps].y, gz[ps].z, gz[ps].w};
    float o[8];
#pragma unroll
    for (int c2 = 0; c2 < 4; c2++) { o[2 * c2] = __uint_as_float(ow_[c2] << 16); o[2 * c2 + 1] = __uint_as_float(ow_[c2] & 0xffff0000u); }
    float ss = 0.f;
#pragma unroll
    for (int c = 0; c < 8; c++) ss += o[c] * o[c];
    ss = row16_sum(ss);
    const float rstd = rsqrtf(ss * (1.f / 128.f) + EPS);
    unsigned out[4];
#pragma unroll
    for (int c2 = 0; c2 < 4; c2++) {
      const float z0 = __uint_as_float(gw[c2] << 16), z1 = __uint_as_float(gw[c2] & 0xffff0000u);
      out[c2] = cvt_pk_bf16(o[2 * c2] * rstd * nwv[2 * c2] * silu_f(z0), o[2 * c2 + 1] * rstd * nwv[2 * c2 + 1] * silu_f(z1));
    }
    *(uint4*)(p.mixed + (grow0 + tok) * D_MODEL + 512 + hd * 128 + d0) = make_uint4(out[0], out[1], out[2], out[3]);
  }
}

#define KLD 72
__device__ void attn_tile(const Params& p, const int bh, const int qb, char* smem) {
  bf16_t* Ks = (bf16_t*)smem;
  bf16_t* Vt = Ks + 64 * KLD;
  int tid = threadIdx.x;
  asm volatile("" : "+v"(tid));
  const int lane = tid & 63, wid = tid >> 6;
  const int r = lane & 31, hh = lane >> 5;
  const int b = bh >> 3, hd = bh & 7;
  const int q0 = qb * 256;
  const int tq = q0 + wid * 32 + r;
  const size_t qrow = (size_t)b * T_SEQ + tq;
  bf16x8 bQ[4];
#pragma unroll
  for (int s = 0; s < 4; s++) bQ[s] = *(const bf16x8*)(p.proj + qrow * NPROJ + hd * 64 + s * 16 + hh * 8);
  f32x16 O[2];
#pragma unroll
  for (int i = 0; i < 2; i++)
#pragma unroll
    for (int e = 0; e < 16; e++) O[i][e] = 0.f;
  float R = 1.f;
  const int tmin = q0 + wid * 32;
  const int lkey = tid >> 3, lc = (tid & 7) * 8;
  const bf16_t* kvbase = p.proj + ((size_t)b * T_SEQ + lkey) * NPROJ + hd * 64 + lc;
  const int vkey = tid & 63, vd0 = (tid >> 6) * 8;
  const bf16_t* vbase = p.proj + ((size_t)b * T_SEQ + vkey) * NPROJ + 1024 + hd * 64 + vd0;
  uint4 kv, vv, kv1, vv1;
  {
    const size_t off = (size_t)(qb * 4 + 3) * 64 * NPROJ;
    kv = *(const uint4*)(kvbase + off + 512);
    vv = *(const uint4*)(vbase + off);
    kv1 = *(const uint4*)(kvbase + off - (size_t)64 * NPROJ + 512);
    vv1 = *(const uint4*)(vbase + off - (size_t)64 * NPROJ);
  }
  for (int kt = qb * 4 + 3; kt >= 0; kt--) {
    const int k0 = kt * 64;
    {
      volatile int* fl = (volatile int*)(smem + CTRL_OFF + 16);
      const bool wany = __ballot(R > ATTN_DEAD) != 0ull;
      if (lane == 0) fl[wid] = wany ? 1 : 0;
      __syncthreads();
      const int any = fl[0] | fl[1] | fl[2] | fl[3] | fl[4] | fl[5] | fl[6] | fl[7];
      if (!any) break;
    }
    {
      *(uint4*)(Ks + lkey * KLD + lc) = kv;
      const unsigned vw[4] = {vv.x, vv.y, vv.z, vv.w};
#pragma unroll
      for (int e = 0; e < 4; e++) {
        Vt[(vd0 + 2 * e) * KLD + vkey] = (bf16_t)(vw[e] & 0xffffu);
        Vt[(vd0 + 2 * e + 1) * KLD + vkey] = (bf16_t)(vw[e] >> 16);
      }
    }
    __syncthreads();
    kv = kv1; vv = vv1;
    if (kt > 1) {
      const size_t off = (size_t)(kt - 2) * 64 * NPROJ;
      kv1 = *(const uint4*)(kvbase + off + 512);
      vv1 = *(const uint4*)(vbase + off);
    }
    if (k0 > tmin + 30) continue;
    if (__ballot(R > ATTN_DEAD) == 0ull) continue;
#pragma unroll
    for (int kb = 1; kb >= 0; kb--) {
      if (k0 + kb * 32 > tmin + 30) continue;
      const bool diag = (k0 + kb * 32 + 31 >= tmin);
      bf16x8 aKf[4];
      bf16x4 vlo[2][2], vhi[2][2];
#pragma unroll
      for (int s = 0; s < 4; s++) aKf[s] = *(const bf16x8*)(Ks + (kb * 32 + r) * KLD + s * 16 + hh * 8);
#pragma unroll
      for (int s = 0; s < 2; s++)
#pragma unroll
        for (int m2 = 0; m2 < 2; m2++) {
          const bf16_t* vp = Vt + (m2 * 32 + r) * KLD + kb * 32 + 16 * s + 4 * hh;
          vlo[s][m2] = *(const bf16x4*)vp;
          vhi[s][m2] = *(const bf16x4*)(vp + 8);
        }
      __builtin_amdgcn_sched_barrier(0);
      f32x16 z;
#pragma unroll
      for (int e = 0; e < 16; e++) z[e] = 0.f;
#pragma unroll
      for (int s = 0; s < 4; s++) z = __builtin_amdgcn_mfma_f32_32x32x16_bf16(aKf[s], bQ[s], z, 0, 0, 0);
      float ev[16], fv[16];
#pragma unroll
      for (int e = 0; e < 16; e++) {
        float ex = __builtin_amdgcn_exp2f(fminf(z[e], 100.f));
        if (diag) {
          const int key = k0 + kb * 32 + (e & 3) + 8 * (e >> 2) + 4 * hh;
          if (key >= tq) ex = 0.f;
        }
        ev[e] = ex;
        fv[e] = __builtin_amdgcn_rcpf(1.f + ex);
      }
      float pv[16];
#pragma unroll
      for (int g = 3; g >= 0; g--) {
        const float s3 = fv[4 * g + 3];
        const float s2 = fv[4 * g + 2] * s3;
        const float s1 = fv[4 * g + 1] * s2;
        const float s0 = fv[4 * g] * s1;
        const float Lp = xchg32(s0, hh);
        const float c = hh ? R : R * Lp;
        pv[4 * g + 3] = ev[4 * g + 3] * s3 * c;
        pv[4 * g + 2] = ev[4 * g + 2] * s2 * c;
        pv[4 * g + 1] = ev[4 * g + 1] * s1 * c;
        pv[4 * g] = ev[4 * g] * s0 * c;
        R = R * s0 * Lp;
      }
#pragma unroll
      for (int s = 0; s < 2; s++) {
        union { unsigned u[4]; bf16x8 v; } pfu;
#pragma unroll
        for (int j = 0; j < 4; j++) pfu.u[j] = cvt_pk_bf16(pv[8 * s + 2 * j], pv[8 * s + 2 * j + 1]);
        const bf16x8 pf = pfu.v;
#pragma unroll
        for (int m2 = 0; m2 < 2; m2++) {
          const bf16x4 lo = vlo[s][m2], hi = vhi[s][m2];
          bf16x8 aV;
          aV[0] = lo[0]; aV[1] = lo[1]; aV[2] = lo[2]; aV[3] = lo[3];
          aV[4] = hi[0]; aV[5] = hi[1]; aV[6] = hi[2]; aV[7] = hi[3];
          O[m2] = __builtin_amdgcn_mfma_f32_32x32x16_bf16(aV, pf, O[m2], 0, 0, 0);
        }
      }
    }
  }
  float ss = 0.f;
#pragma unroll
  for (int i = 0; i < 2; i++)
#pragma unroll
    for (int e = 0; e < 16; e++) ss += O[i][e] * O[i][e];
  ss += xchg32(ss, hh);
  const float rstd = rsqrtf(ss * (1.f / 64.f) + EPS);
#pragma unroll
  for (int i = 0; i < 2; i++)
#pragma unroll
    for (int g = 0; g < 4; g++) {
      const int d0 = i * 32 + 8 * g + 4 * hh;
      const bf16x4 zz = *(const bf16x4*)(p.proj + qrow * NPROJ + 1536 + hd * 64 + d0);
      const float4 nw = *(const float4*)(p.sb_norm_w + d0);
      const float nwv[4] = {nw.x, nw.y, nw.z, nw.w};
      float ob[4];
#pragma unroll
      for (int c = 0; c < 4; c++) ob[c] = O[i][4 * g + c] * rstd * nwv[c] * silu_f(bf2f((bf16_t)zz[c]));
      *(uint2*)(p.mixed + qrow * D_MODEL + hd * 64 + d0) = make_uint2(cvt_pk_bf16(ob[0], ob[1]), cvt_pk_bf16(ob[2], ob[3]));
    }
}

__device__ void final_norm(const Params& p) {
  const int tid = threadIdx.x, lane = tid & 63, wid = tid >> 6;
  const int gw = blockIdx.x * 8 + wid, nw = gridDim.x * 8;
  for (int row = gw; row < M_TOK; row += nw) {
    float4* yr = (float4*)(p.out + (size_t)row * D_MODEL);
    float4 v[4];
    float ss = 0.f;
#pragma unroll
    for (int i = 0; i < 4; i++) {
      v[i] = yr[lane + 64 * i];
      ss += v[i].x * v[i].x + v[i].y * v[i].y + v[i].z * v[i].z + v[i].w * v[i].w;
    }
    ss = wave_sum(ss);
    const float rstd = rsqrtf(ss * (1.f / D_MODEL) + EPS);
#pragma unroll
    for (int i = 0; i < 4; i++) {
      const float4 w = ((const float4*)p.final_w)[lane + 64 * i];
      float4 o;
      o.x = v[i].x * rstd * w.x; o.y = v[i].y * rstd * w.y; o.z = v[i].z * rstd * w.z; o.w = v[i].w * rstd * w.w;
      yr[lane + 64 * i] = o;
    }
  }
}

__device__ void attn_tile2(const Params& p, const int bh, const int qb) {
  int tid = threadIdx.x;
  asm volatile("" : "+v"(tid));
  const int lane = tid & 63, wid = tid >> 6;
  const int r = lane & 31, hh = lane >> 5;
  const int b = bh >> 3, hd = bh & 7;
  const int tmin = qb * 256 + wid * 32;
  const int tq = tmin + r;
  const size_t qrow = (size_t)b * T_SEQ + tq;
  bf16x8 bQ[4];
#pragma unroll
  for (int s = 0; s < 4; s++) bQ[s] = *(const bf16x8*)(p.proj + qrow * NPROJ + hd * 64 + s * 16 + hh * 8);
  f32x16 O[2];
#pragma unroll
  for (int i = 0; i < 2; i++)
#pragma unroll
    for (int e = 0; e < 16; e++) O[i][e] = 0.f;
  float R = 1.f;
  const bf16_t* kbase = p.proj + ((size_t)b * T_SEQ + r) * NPROJ + 512 + hd * 64 + hh * 8;
  const bf16_t* vbase = p.proj + ((size_t)b * T_SEQ + r) * NPROJ + 1024 + hd * 64 + 4 * hh;
  bf16x8 aKn[4];
  uint2 vln[2][2], vhn[2][2];
#define A2_LOAD(ks_)                                                                              \
  {                                                                                               \
    const int k0_ = (ks_) * 32, tb_ = k0_ & ~63, kl_ = k0_ & 63;                                  \
    _Pragma("unroll") for (int s = 0; s < 4; s++) aKn[s] = *(const bf16x8*)(kbase + (size_t)k0_ * NPROJ + s * 16); \
    _Pragma("unroll") for (int s = 0; s < 2; s++)                                                 \
      _Pragma("unroll") for (int m2 = 0; m2 < 2; m2++) {                                          \
        const bf16_t* vp_ = vbase + (size_t)(tb_ + m2 * 32) * NPROJ + kl_ + 16 * s;               \
        vln[s][m2] = *(const uint2*)vp_; vhn[s][m2] = *(const uint2*)(vp_ + 8);                   \
      }                                                                                           \
  }
  int ks = tmin >> 5;
  A2_LOAD(ks);
  for (; ks >= 0; ks--) {
    const int k0 = ks * 32;
    bf16x8 aK[4];
    uint2 vl[2][2], vh[2][2];
#pragma unroll
    for (int s = 0; s < 4; s++) aK[s] = aKn[s];
#pragma unroll
    for (int s = 0; s < 2; s++)
#pragma unroll
      for (int m2 = 0; m2 < 2; m2++) { vl[s][m2] = vln[s][m2]; vh[s][m2] = vhn[s][m2]; }
    if (ks > 0) A2_LOAD(ks - 1);
    const bool diag = (k0 + 31 >= tmin);
    f32x16 z;
#pragma unroll
    for (int e = 0; e < 16; e++) z[e] = 0.f;
#pragma unroll
    for (int s = 0; s < 4; s++) z = __builtin_amdgcn_mfma_f32_32x32x16_bf16(aK[s], bQ[s], z, 0, 0, 0);
    float ev[16], fv[16];
#pragma unroll
    for (int e = 0; e < 16; e++) {
      float ex = __builtin_amdgcn_exp2f(fminf(z[e], 100.f));
      if (diag) {
        const int key = k0 + (e & 3) + 8 * (e >> 2) + 4 * hh;
        if (key >= tq) ex = 0.f;
      }
      ev[e] = ex;
      fv[e] = __builtin_amdgcn_rcpf(1.f + ex);
    }
    float pv[16];
#pragma unroll
    for (int g = 3; g >= 0; g--) {
      const float s3 = fv[4 * g + 3];
      const float s2 = fv[4 * g + 2] * s3;
      const float s1 = fv[4 * g + 1] * s2;
      const float s0 = fv[4 * g] * s1;
      const float Lp = xchg32(s0, hh);
      const float c = hh ? R : R * Lp;
      pv[4 * g + 3] = ev[4 * g + 3] * s3 * c;
      pv[4 * g + 2] = ev[4 * g + 2] * s2 * c;
      pv[4 * g + 1] = ev[4 * g + 1] * s1 * c;
      pv[4 * g] = ev[4 * g] * s0 * c;
      R = R * s0 * Lp;
    }
#pragma unroll
    for (int s = 0; s < 2; s++) {
      union { unsigned u[4]; bf16x8 v; } pfu;
#pragma unroll
      for (int j = 0; j < 4; j++) pfu.u[j] = cvt_pk_bf16(pv[8 * s + 2 * j], pv[8 * s + 2 * j + 1]);
#pragma unroll
      for (int m2 = 0; m2 < 2; m2++) {
        union { unsigned u[4]; bf16x8 v; } avu;
        avu.u[0] = vl[s][m2].x; avu.u[1] = vl[s][m2].y; avu.u[2] = vh[s][m2].x; avu.u[3] = vh[s][m2].y;
        O[m2] = __builtin_amdgcn_mfma_f32_32x32x16_bf16(avu.v, pfu.v, O[m2], 0, 0, 0);
      }
    }
    if (__ballot(R > ATTN_DEAD) == 0ull) break;
  }
#undef A2_LOAD
  float ss = 0.f;
#pragma unroll
  for (int i = 0; i < 2; i++)
#pragma unroll
    for (int e = 0; e < 16; e++) ss += O[i][e] * O[i][e];
  ss += xchg32(ss, hh);
  const float rstd = rsqrtf(ss * (1.f / 64.f) + EPS);
#pragma unroll
  for (int i = 0; i < 2; i++)
#pragma unroll
    for (int g = 0; g < 4; g++) {
      const int d0 = i * 32 + 8 * g + 4 * hh;
      const bf16x4 zz = *(const bf16x4*)(p.proj + qrow * NPROJ + 1536 + hd * 64 + d0);
      const float4 nw = *(const float4*)(p.sb_norm_w + d0);
      const float nwv[4] = {nw.x, nw.y, nw.z, nw.w};
      float ob[4];
#pragma unroll
      for (int c = 0; c < 4; c++) ob[c] = O[i][4 * g + c] * rstd * nwv[c] * silu_f(bf2f((bf16_t)zz[c]));
      *(uint2*)(p.mixed + qrow * D_MODEL + hd * 64 + d0) = make_uint2(cvt_pk_bf16(ob[0], ob[1]), cvt_pk_bf16(ob[2], ob[3]));
    }
}

#define SMEM_BYTES (152 * 1024)
__global__ void __launch_bounds__(NTHREADS) fwd_megakernel(Params p) {
  extern __shared__ __attribute__((aligned(16))) char smem[];
  cg::grid_group grid = cg::this_grid();
  volatile int* s_item_p = (volatile int*)(smem + CTRL_OFF);
  if (p.coop_flag) grid.sync();
  if (threadIdx.x < 4) ((volatile unsigned*)(smem + CTRL_OFF + 48))[threadIdx.x] = 0u;
  __syncthreads();
  XcdBarrier xb = xcd_barrier_post(p.bar, (volatile LAS unsigned*)(smem + CTRL_OFF + 48));

#ifndef NO_P0
  phase0(p, smem);
#ifdef REP_P0
  phase0(p, smem);
#endif
#endif
  xcd_barrier(xb);
  {
    pg8::Gemm g{p.h, p.Wt, M_TOK, NPROJ, 1024};
    pg8::StaticOrder S; S.init(M_TOK, NPROJ, gridDim.x, blockIdx.x);
    pg8::EpiProj E{p.proj};
    pg8::gemm_phase<pg8::EpiProj, pg8::StaticOrder, false>((PG8_LAS unsigned char*)smem, g, S, E, nullptr);
#ifdef REP_G0
    pg8::gemm_phase<pg8::EpiProj, pg8::StaticOrder, false>((PG8_LAS unsigned char*)smem, g, S, E, nullptr);
#endif
  }
  xcd_barrier(xb);
#if defined(REP_MERGED) && REP_MERGED > 0
  for (int rep = 0; rep < 2; rep++)
#else
  const int rep = 0;
#endif
  {
#define NEXT_ITEM()                                                              \
  {                                                                              \
    __syncthreads();                                                             \
    if (threadIdx.x == 0) *s_item_p = (int)atomicAdd(&p.counters[rep], 1u);      \
    __syncthreads();                                                             \
    item = *s_item_p;                                                            \
  }
    int item;
    NEXT_ITEM();
#ifndef REP_MERGED
#define REP_MERGED 0
#define REP_MERGED_UNDEF
#endif
    while (item < SCAN_AT) {
      if (!(rep == 1 && REP_MERGED == 2)) gdn_prep(p, (item & 31) * 32 + (item >> 5), smem, 3, rep * 1024);
      NEXT_ITEM();
    }
    while (item < SCAN_AT + 32) {
      if (!(rep == 1 && REP_MERGED == 2)) gdn_scan(p, item - SCAN_AT, smem, 0, rep * 1024);
      NEXT_ITEM();
    }
    while (item < 1056) {
      const int k = item - 32;
      if (!(rep == 1 && REP_MERGED == 2)) gdn_prep(p, (k & 31) * 32 + (k >> 5), smem, 3, rep * 1024);
      NEXT_ITEM();
    }
    while (item < 1568) {
      const int j = item - 1056;
      if (!(rep == 1 && REP_MERGED == 3)) attn_tile2(p, j & 63, 7 - (j >> 6));
      NEXT_ITEM();
    }
#undef NEXT_ITEM
    xcd_barrier(xb);
  }
  for (int t = blockIdx.x; t < 1024; t += gridDim.x) gdn_normgate(p, t);
#ifdef REP_NG
  for (int r_ = 0; r_ < 4; r_++) for (int t = blockIdx.x; t < 1024; t += gridDim.x) gdn_normgate(p, t);
#endif
  xcd_barrier(xb);
  {
    pg8::Gemm g{p.mixed, p.WoT, M_TOK, D_MODEL, 1024};
    pg8::StaticOrder S; S.init(M_TOK, D_MODEL, gridDim.x, blockIdx.x);
    pg8::EpiOutNorm E{p.out, p.x, p.final_w, p.rowss, p.pcnt};
    pg8::gemm_phase<pg8::EpiOutNorm, pg8::StaticOrder, false>((PG8_LAS unsigned char*)smem, g, S, E, nullptr);
#ifdef REP_G1
    xcd_barrier(xb);
    pg8::EpiOutNorm E2{p.out, p.x, p.final_w, p.rowss + 16384 + 64, p.pcnt + 16384 + 64};
    pg8::gemm_phase<pg8::EpiOutNorm, pg8::StaticOrder, false>((PG8_LAS unsigned char*)smem, g, S, E2, nullptr);
#endif
  }

}

extern "C" void kernel_launch(void* const* d_in, const int* in_sizes, int n_in, void* d_out, int out_size,
                              void* d_ws, size_t ws_size, hipStream_t stream) {
  static int grid_blocks = 0;
  if (!grid_blocks) {
    int dev = 0, cus = 0, per_cu = 0;
    hipGetDevice(&dev);
    hipDeviceGetAttribute(&cus, hipDeviceAttributeMultiprocessorCount, dev);
    hipFuncSetAttribute((const void*)fwd_megakernel, hipFuncAttributeMaxDynamicSharedMemorySize, SMEM_BYTES);
    hipOccupancyMaxActiveBlocksPerMultiprocessor(&per_cu, fwd_megakernel, NTHREADS, SMEM_BYTES);
    if (per_cu < 1) per_cu = 1;
    grid_blocks = cus * per_cu;
  }
  Params p{};
  p.x = (const float*)d_in[0]; p.norm1_w = (const float*)d_in[1]; p.w_in = (const float*)d_in[2];
  p.sb_norm_w = (const float*)d_in[3]; p.conv_w = (const float*)d_in[4]; p.A_log = (const float*)d_in[5];
  p.dt_bias = (const float*)d_in[6]; p.gdn_norm_w = (const float*)d_in[7]; p.w_out = (const float*)d_in[8];
  p.final_w = (const float*)d_in[9];
  p.out = (float*)d_out;
  char* ws = (char*)d_ws;
  const size_t MiB = 1024 * 1024;
  p.Wt = (bf16_t*)(ws + 0 * MiB);
  p.WoT = (bf16_t*)(ws + 8 * MiB);
  p.gba = (float*)(ws + 10 * MiB);
  p.counters = (unsigned*)(ws + 10 * MiB + 512 * 1024);
  p.eglast = (float*)(ws + 10 * MiB + 512 * 1024 + 4096);
  p.h = (bf16_t*)(ws + 11 * MiB);
  p.mixed = (bf16_t*)(ws + 11 * MiB);
  p.proj = (bf16_t*)(ws + 43 * MiB);
  p.U = (bf16_t*)(ws + 171 * MiB);
  p.W = (bf16_t*)(ws + 187 * MiB);
  p.QG = (bf16_t*)(ws + 203 * MiB);
  p.KDt = (bf16_t*)(ws + 219 * MiB);
  p.AI = (bf16_t*)(ws + 235 * MiB);
  p.bar = (unsigned*)(ws + 10 * MiB + 512 * 1024 + 8192);
  p.flags = (unsigned*)(ws + 10 * MiB + 512 * 1024 + 24576);
  p.coop_flag = 0u; p.pad_ = 0u;
  p.rowss = (float*)(ws + 10 * MiB + 512 * 1024 + 32768);
  p.pcnt = (unsigned*)(ws + 10 * MiB + 512 * 1024 + 32768 + 65536);

#ifdef REP_G1
  hipMemsetAsync(p.counters, 0, 32768 + 2 * (65536 + 256), stream);
#else
  hipMemsetAsync(p.counters, 0, 32768 + 65536 + 256, stream);
#endif
  void* args[] = {&p};
  hipError_t e = hipLaunchCooperativeKernel((void*)fwd_megakernel, dim3(grid_blocks), dim3(NTHREADS), args,
                                            SMEM_BYTES, stream);
  if (e != hipSuccess) fprintf(stderr, "cooperative launch failed: %s (grid %d)\n", hipGetErrorString(e), grid_blocks);
}
```

```cpp
#include <hip/hip_runtime.h>
#include <hip/hip_bf16.h>
#include <hip/hip_cooperative_groups.h>
#include <cstdio>
namespace cg = cooperative_groups;

typedef unsigned short bf16_t;
using bf16x8 = __attribute__((ext_vector_type(8))) short;
using bf16x4 = __attribute__((ext_vector_type(4))) short;
using f32x16 = __attribute__((ext_vector_type(16))) float;
using f32x4 = __attribute__((ext_vector_type(4))) float;

#define NTHREADS 512
#define DYN_QUEUE 1
#define M_TOK 16384
#define T_SEQ 2048
#define D_MODEL 1024
#define D_IN 4104
#define NPROJ 4096
#define EPS 1e-6f
#define QSCALE 0.18033688011112042f
#define ATTN_DEAD 1e-12f
#ifndef SCAN_AT
#define SCAN_AT 512
#endif

struct Params {
  const float* x; const float* norm1_w; const float* w_in; const float* sb_norm_w;
  const float* conv_w; const float* A_log; const float* dt_bias; const float* gdn_norm_w;
  const float* w_out; const float* final_w;
  float* out;
  bf16_t* Wt; bf16_t* WoT; float* gba; unsigned* counters; float* eglast;
  bf16_t* h; bf16_t* mixed; bf16_t* proj;
  bf16_t* U; bf16_t* W; bf16_t* QG; bf16_t* KDt; bf16_t* AI;
  unsigned* bar; unsigned* flags; float* rowss; unsigned* pcnt; unsigned coop_flag; unsigned pad_;
};

__device__ __forceinline__ bf16_t f2bf(float f) { return __builtin_bit_cast(unsigned short, (__bf16)f); }
__device__ __forceinline__ float bf2f(bf16_t b) { return __uint_as_float(((unsigned)b) << 16); }
template <int CTRL> __device__ __forceinline__ float dpp_mov(float v) {
  return __int_as_float(__builtin_amdgcn_update_dpp(0, __float_as_int(v), CTRL, 0xf, 0xf, true));
}
__device__ __forceinline__ float row16_sum(float v) {
  v += dpp_mov<0xB1>(v);
  v += dpp_mov<0x4E>(v);
  v += dpp_mov<0x141>(v);
  v += dpp_mov<0x140>(v);
  return v;
}
__device__ __forceinline__ float xchg32(float x, int hh);
__device__ __forceinline__ float wave_sum(float v) {
  v = row16_sum(v);
  v += __shfl_xor(v, 16);
  v += xchg32(v, (int)(threadIdx.x & 63) >> 5);
  return v;
}
__device__ __forceinline__ float xchg32(float x, int hh) {
  const unsigned u = __float_as_uint(x);
  const auto r = __builtin_amdgcn_permlane32_swap(u, u, false, false);
  return __uint_as_float(hh ? r[0] : r[1]);
}
__device__ __forceinline__ float silu_f(float x) { return x * __builtin_amdgcn_rcpf(1.f + __expf(-x)); }
typedef __bf16 bf16x2_nat __attribute__((ext_vector_type(2)));
__device__ __forceinline__ unsigned cvt_pk_bf16(float lo, float hi) {
  bf16x2_nat v;
  v[0] = (__bf16)lo; v[1] = (__bf16)hi;
  return __builtin_bit_cast(unsigned, v);
}

typedef unsigned u32x4_t __attribute__((ext_vector_type(4)));
__device__ __forceinline__ void st_wt_b128(void* ptr, unsigned a, unsigned b, unsigned c, unsigned d) {
  u32x4_t v = {a, b, c, d};
  asm volatile("global_store_dwordx4 %0, %1, off sc1\n\ts_nop 1" :: "v"(ptr), "v"(v) : "memory");
}
__device__ __forceinline__ void st_wt_b32(void* ptr, unsigned v) {
  asm volatile("global_store_dword %0, %1, off sc1" :: "v"(ptr), "v"(v) : "memory");
}
__device__ __forceinline__ void st_wt_b16(void* ptr, unsigned v) {
  asm volatile("global_store_short %0, %1, off sc1" :: "v"(ptr), "v"(v) : "memory");
}

#define XB_TMO      128
#define XB_XCNT(j)  (256  + 64 * (j))
#define XB_XSUB(j)  (1280 + 64 * (j))
#define XB_XGEN(j)  (2304 + 64 * (j))
#define XB_TOP      3328
#define XB_TOPGEN   3392
#define XCD_BAR_WORDS 3456
#define XB_SPIN_CAP (1u << 18)
#define LAS __attribute__((address_space(3)))

__device__ __forceinline__ unsigned xb_ld(unsigned* p)              { return __hip_atomic_load(p, __ATOMIC_RELAXED, __HIP_MEMORY_SCOPE_AGENT); }
__device__ __forceinline__ unsigned xb_add(unsigned* p, unsigned v) { return __hip_atomic_fetch_add(p, v, __ATOMIC_RELAXED, __HIP_MEMORY_SCOPE_AGENT); }
__device__ __forceinline__ unsigned xb_xcc_id() { return (unsigned)__builtin_amdgcn_s_getreg((3 << 11) | 20) & 0xFu; }
#define XB_SPIN(cond, bar) do { unsigned _sp = 0; while (cond) { __builtin_amdgcn_s_sleep(1); \
    if ((++_sp & 255u) == 0u) { if (xb_ld(&(bar)[XB_TMO])) break; if (_sp > XB_SPIN_CAP) { atomicAdd(&(bar)[XB_TMO], 1u); break; } } } } while (0)

struct XcdBarrier {
    unsigned* bar; unsigned x;
    volatile LAS unsigned* st;
};

__device__ __forceinline__ XcdBarrier xcd_barrier_post(unsigned* bar, volatile LAS unsigned* st) {
    XcdBarrier b; b.bar = bar; b.x = xb_xcc_id(); b.st = st;
    if (threadIdx.x == 0) (void)xb_add(&bar[XB_XCNT(b.x)], 1u);
    return b;
}
__device__ __forceinline__ void xcd_barrier_complete(unsigned* bar, unsigned x, unsigned& nloc, unsigned& nx) {
    const unsigned G = gridDim.x * gridDim.y * gridDim.z;
    unsigned sum, cnt, mine, sp = 0u;
    for (;;) {
        sum = 0u; cnt = 0u; mine = 0u;
#pragma unroll
        for (unsigned j = 0; j < 16; ++j) { const unsigned c = xb_ld(&bar[XB_XCNT(j)]); sum += c; cnt += (c > 0u) ? 1u : 0u; mine = (j == x) ? c : mine; }
        if (sum == G) break;
        __builtin_amdgcn_s_sleep(1);
        if ((++sp & 255u) == 0u) { if (xb_ld(&bar[XB_TMO])) break; if (sp > XB_SPIN_CAP) { atomicAdd(&bar[XB_TMO], 1u); break; } }
    }
    nloc = mine > 0u ? mine : 1u; nx = cnt > 0u ? cnt : 1u;
}

__device__ __forceinline__ void xcd_barrier(const XcdBarrier& b) {
    asm volatile("s_waitcnt vmcnt(0)" ::: "memory");
    __syncthreads();
    if (threadIdx.x == 0) {
        unsigned* bar = b.bar;
        __builtin_amdgcn_s_waitcnt(0);
        unsigned nloc = b.st[0], nx = b.st[1];
        if (nloc == 0u) { xcd_barrier_complete(bar, b.x, nloc, nx); b.st[0] = nloc; b.st[1] = nx; }
        const unsigned old = xb_add(&bar[XB_XSUB(b.x)], 1u);
        const unsigned gen = old / nloc;
        if (old + 1u == (gen + 1u) * nloc) {
            __builtin_amdgcn_fence(__ATOMIC_RELEASE, "agent");
            asm volatile("s_waitcnt vmcnt(0)" ::: "memory");
            const unsigned og = xb_add(&bar[XB_TOP], 1u);
            const unsigned tg = og / nx;
            if (og + 1u == (tg + 1u) * nx) xb_add(&bar[XB_TOPGEN], 1u);
            else XB_SPIN(xb_ld(&bar[XB_TOPGEN]) == tg, bar);
            __builtin_amdgcn_fence(__ATOMIC_ACQUIRE, "agent");
            xb_add(&bar[XB_XGEN(b.x)], 1u);
            asm volatile("s_waitcnt vmcnt(0)" ::: "memory");
        } else {
            XB_SPIN(xb_ld(&bar[XB_XGEN(b.x)]) == gen, bar);
            __builtin_amdgcn_fence(__ATOMIC_ACQUIRE, "agent");
            asm volatile("s_waitcnt vmcnt(0)" ::: "memory");
        }
    }
    __syncthreads();
}


__device__ void phase0(const Params& p, char* smem) {
  const int tid = threadIdx.x, lane = tid & 63, wid = tid >> 6;
  float* wg = (float*)(smem + 32768);
  for (int k = tid; k < 1024; k += NTHREADS) {
    const float4* wp = (const float4*)(p.w_in + (size_t)k * D_IN + NPROJ);
    const float4 wa = wp[0], wb = wp[1];
    wg[0 * 1024 + k] = wa.x; wg[1 * 1024 + k] = wa.y; wg[2 * 1024 + k] = wa.z; wg[3 * 1024 + k] = wa.w;
    wg[4 * 1024 + k] = wb.x; wg[5 * 1024 + k] = wb.y; wg[6 * 1024 + k] = wb.z; wg[7 * 1024 + k] = wb.w;
  }
  __syncthreads();
  const int gw = blockIdx.x * 8 + wid, nw = gridDim.x * 8;
#pragma unroll 2
  for (int row = gw; row < M_TOK; row += nw) {
    const float4* xr = (const float4*)(p.x + (size_t)row * D_MODEL);
    float4 v[4];
    float ss = 0.f;
#pragma unroll
    for (int i = 0; i < 4; i++) {
      {
        const f32x4 t_ = __builtin_nontemporal_load((const f32x4*)(xr + lane + 64 * i));
        v[i] = make_float4(t_[0], t_[1], t_[2], t_[3]);
      }
      ss += v[i].x * v[i].x + v[i].y * v[i].y + v[i].z * v[i].z + v[i].w * v[i].w;
    }
    ss = wave_sum(ss);
    const float rstd = rsqrtf(ss * (1.f / D_MODEL) + EPS);
    float a[8];
#pragma unroll
    for (int c = 0; c < 8; c++) a[c] = 0.f;
#pragma unroll
    for (int i = 0; i < 4; i++) {
      const float4 w = ((const float4*)p.norm1_w)[lane + 64 * i];
      float hv[4];
      hv[0] = v[i].x * rstd * w.x; hv[1] = v[i].y * rstd * w.y;
      hv[2] = v[i].z * rstd * w.z; hv[3] = v[i].w * rstd * w.w;
      bf16x4 hb;
      hb[0] = (short)f2bf(hv[0]); hb[1] = (short)f2bf(hv[1]); hb[2] = (short)f2bf(hv[2]); hb[3] = (short)f2bf(hv[3]);
      *(bf16x4*)(p.h + (size_t)row * D_MODEL + (lane + 64 * i) * 4) = hb;
#pragma unroll
      for (int c = 0; c < 8; c++) {
        const float4 wv = *(const float4*)(wg + c * 1024 + (lane + 64 * i) * 4);
        a[c] += hv[0] * wv.x + hv[1] * wv.y + hv[2] * wv.z + hv[3] * wv.w;
      }
    }
#pragma unroll
    for (int c = 0; c < 8; c++) a[c] = wave_sum(a[c]);
    if (lane == 0) {
      float4* g = (float4*)(p.gba + (size_t)row * 8);
      g[0] = make_float4(a[0], a[1], a[2], a[3]);
      g[1] = make_float4(a[4], a[5], a[6], a[7]);
    }
  }
  float* tile = (float*)smem;
  const int tx = tid & 63, ty = tid >> 6;
  for (int t = blockIdx.x; t < 1280; t += gridDim.x) {
    const float* src; bf16_t* dst; int ld, k0, n0;
    if (t < 1024) { src = p.w_in; ld = D_IN; k0 = (t >> 6) * 64; n0 = (t & 63) * 64; dst = p.Wt; }
    else { const int u = t - 1024; src = p.w_out; ld = 1024; k0 = (u >> 4) * 64; n0 = (u & 15) * 64; dst = p.WoT; }
#pragma unroll
    for (int it = 0; it < 2; it++) {
      const int idx = tid + it * NTHREADS, k = idx >> 4, n4 = (idx & 15) * 4;
      const float4 v4 = *(const float4*)(src + (size_t)(k0 + k) * ld + n0 + n4);
      float* tp = tile + k * 65 + n4;
      tp[0] = v4.x; tp[1] = v4.y; tp[2] = v4.z; tp[3] = v4.w;
    }
    __syncthreads();
#pragma unroll
    for (int it = 0; it < 2; it++) {
      const int idx = tid + it * NTHREADS, n = idx >> 4, k4 = (idx & 15) * 4;
      const float* tp = tile + k4 * 65 + n;
      *(uint2*)(dst + (size_t)(n0 + n) * 1024 + k0 + k4) = make_uint2(cvt_pk_bf16(tp[0], tp[65]), cvt_pk_bf16(tp[130], tp[195]));
    }
    __syncthreads();
  }
}

#include <hip/hip_runtime.h>
namespace pg8 {
#define PG8_LAS __attribute__((address_space(3)))
typedef unsigned short bf16_t;
typedef short bf16x8 __attribute__((ext_vector_type(8)));
typedef float f32x4 __attribute__((ext_vector_type(4)));
typedef unsigned u32x4 __attribute__((ext_vector_type(4)));
constexpr int BM = 256, BK = 64, HALF = 128, HTB = HALF * BK * 2  , STAGE_BYTES = 8 * HTB, NXCD = 8, WGM = 8;

__host__ __device__ __forceinline__ int lds_byte(int r, int c) { const int st = (r >> 4) * 2 + (c >> 5), rr = r & 15, cc = c & 31, ob = rr * 64 + cc * 2; return st * 1024 + (ob ^ (((ob >> 9) & 1) << 5)); }
__host__ __device__ __forceinline__ void stage_rc(int b, int& R, int& C) { const int st = b / 1024, sb = b % 1024, swz = sb ^ (((sb >> 9) & 1) << 5); R = (st >> 1) * 16 + swz / 64; C = (st & 1) * 32 + (swz % 64) / 2; }
__host__ __device__ __forceinline__ int perm32(int rho) { const int n = rho >> 4, i = rho & 15; return 8 * (i >> 2) + 4 * n + (i & 3); }

struct Unit { int pm, pn; };
struct Gemm { const bf16_t* A; const bf16_t* Bt; int M, N, K; };

struct StaticOrder {
    int nM, nN, nwg, G, c;
    __host__ __device__ void init(int M, int N, int G_, int c_) { nM = M / BM; nN = N / BM; nwg = nM * nN; G = G_; c = c_; }
    __host__ __device__ bool next(int i, Unit& u) const {
        const long L = (long)i * G + c; if (L >= nwg) return false;
        int wgid = (int)L; { const int q = nwg / NXCD, r = nwg % NXCD, xcd = wgid % NXCD, off = wgid / NXCD; wgid = (xcd < r ? xcd * (q + 1) : r * (q + 1) + (xcd - r) * q) + off; }
        const int nig = WGM * nN, gid = wgid / nig, fm = gid * WGM, gsz = (nM - fm) < WGM ? (nM - fm) : WGM;
        u.pm = fm + ((wgid % nig) % gsz); u.pn = (wgid % nig) / gsz; return true;
    }
    __device__ __forceinline__ void a_ready(const Unit&) const {}
    __device__ __forceinline__ void done(const Unit&) const {}
};
__device__ __forceinline__ unsigned cvt_pk_bf16(float lo, float hi) { unsigned r; asm volatile("v_cvt_pk_bf16_f32 %0, %1, %2" : "=v"(r) : "v"(lo), "v"(hi)); return r; }

struct EpiProj {
    static constexpr bool PERM = true, AFTER_DRAIN = false;
    bf16_t* O;
    __device__ __forceinline__ void operator()(const f32x4 (&acc)[2][2][4][2], const Unit& u, int wr, int wc, int fr, int fq) const {
        const int row0 = u.pm * BM + wr * 64 + fr; const int colt = u.pn * BM;
        const int col0 = colt + wc * 32 + 8 * fq;
        const float sc = colt < 512 ? 0.18033688011112042f : 1.f;
        if (colt >= 1024 && colt < 1536) {
#pragma unroll
            for (int ai = 0; ai < 2; ++ai)
#pragma unroll
                for (int m = 0; m < 4; ++m) { const int tok = row0 + ai * HALF + m * 16, tb = tok & ~63, tl = tok & 63;
#pragma unroll
                    for (int bj = 0; bj < 2; ++bj) { const int hc = col0 + bj * HALF - 1024, hd = hc >> 6, d0 = hc & 63;
                        bf16_t* bp = O + (size_t)(tb + d0) * 4096 + 1024 + hd * 64 + tl;
                        const f32x4 v0 = acc[ai][bj][m][0], v1 = acc[ai][bj][m][1];
                        const unsigned w0 = cvt_pk_bf16(v0[0], v0[1]), w1 = cvt_pk_bf16(v0[2], v0[3]), w2 = cvt_pk_bf16(v1[0], v1[1]), w3 = cvt_pk_bf16(v1[2], v1[3]);
                        bp[0 * 4096] = (bf16_t)(w0 & 0xffffu); bp[1 * 4096] = (bf16_t)(w0 >> 16);
                        bp[2 * 4096] = (bf16_t)(w1 & 0xffffu); bp[3 * 4096] = (bf16_t)(w1 >> 16);
                        bp[4 * 4096] = (bf16_t)(w2 & 0xffffu); bp[5 * 4096] = (bf16_t)(w2 >> 16);
                        bp[6 * 4096] = (bf16_t)(w3 & 0xffffu); bp[7 * 4096] = (bf16_t)(w3 >> 16); } }
            return;
        }
#pragma unroll
        for (int ai = 0; ai < 2; ++ai)
#pragma unroll
            for (int m = 0; m < 4; ++m) { bf16_t* rowp = O + (size_t)(row0 + ai * HALF + m * 16) * 4096 + col0;
#pragma unroll
                for (int bj = 0; bj < 2; ++bj) { const f32x4 v0 = acc[ai][bj][m][0] * sc, v1 = acc[ai][bj][m][1] * sc;
                    u32x4 w; w.x = cvt_pk_bf16(v0[0], v0[1]); w.y = cvt_pk_bf16(v0[2], v0[3]); w.z = cvt_pk_bf16(v1[0], v1[1]); w.w = cvt_pk_bf16(v1[2], v1[3]);
                    *(u32x4*)(rowp + bj * HALF) = w; } }
    }
};
struct EpiOut {
    static constexpr bool PERM = false, AFTER_DRAIN = false;
    float* C; const float* X;
    __device__ __forceinline__ void operator()(const f32x4 (&acc)[2][2][4][2], const Unit& u, int wr, int wc, int fr, int fq) const {
        const int row0 = u.pm * BM + wr * 64 + fr, col0 = u.pn * BM + wc * 32 + 4 * fq;
#pragma unroll
        for (int ai = 0; ai < 2; ++ai)
#pragma unroll
            for (int m = 0; m < 4; ++m) { const size_t off = (size_t)(row0 + ai * HALF + m * 16) * 1024 + col0;
#pragma unroll
                for (int bj = 0; bj < 2; ++bj)
#pragma unroll
                    for (int n = 0; n < 2; ++n) *(f32x4*)(C + off + bj * HALF + n * 16) = acc[ai][bj][m][n] + *(const f32x4*)(X + off + bj * HALF + n * 16); }
    }
};

struct EpiOutNorm {
    static constexpr bool PERM = false, AFTER_DRAIN = true;
    float* C; const float* X; const float* FW; float* rowss; unsigned* cnt;
    __device__ __forceinline__ void operator()(const f32x4 (&)[2][2][4][2], const Unit&, int, int, int, int) const {}
    __device__ __forceinline__ void fused(f32x4 (&acc)[2][2][4][2], const Unit& u, int wr, int wc, int fr, int fq, PG8_LAS unsigned char* lds, int wid, int lane) const {
        PG8_LAS float* ls = (PG8_LAS float*)lds;
        const int tid = threadIdx.x;
        const int row0 = u.pm * BM + wr * 64 + fr, col0 = u.pn * BM + wc * 32 + 4 * fq;
#pragma unroll
        for (int ai = 0; ai < 2; ++ai)
#pragma unroll
            for (int m = 0; m < 4; ++m) { const size_t off = (size_t)(row0 + ai * HALF + m * 16) * 1024 + col0; float ssq = 0.f;
#pragma unroll
                for (int bj = 0; bj < 2; ++bj)
#pragma unroll
                    for (int n = 0; n < 2; ++n) { f32x4 y = acc[ai][bj][m][n] + *(const f32x4*)(X + off + bj * HALF + n * 16); acc[ai][bj][m][n] = y;
                        ssq += y[0] * y[0] + y[1] * y[1] + y[2] * y[2] + y[3] * y[3]; }
                ssq += __shfl_xor(ssq, 16); ssq += __shfl_xor(ssq, 32);
                if (fq == 0) ls[wc * 256 + ai * HALF + wr * 64 + m * 16 + fr] = ssq; }
        __syncthreads();
        if (tid < 256) {
            const float part = ls[tid] + ls[256 + tid] + ls[512 + tid] + ls[768 + tid];
            const float old = atomicAdd(rowss + u.pm * BM + tid, part);
            asm volatile("" :: "v"(old));
        }
        __syncthreads();
        if (tid == 0) {
            __hip_atomic_fetch_add(cnt + u.pm, 1u, __ATOMIC_RELEASE, __HIP_MEMORY_SCOPE_AGENT);
            while (__hip_atomic_load(cnt + u.pm, __ATOMIC_RELAXED, __HIP_MEMORY_SCOPE_AGENT) < 4u) __builtin_amdgcn_s_sleep(1);
            __builtin_amdgcn_fence(__ATOMIC_ACQUIRE, "agent");
        }
        __syncthreads();
        if (tid < 256) {
            const float tot = __hip_atomic_load(rowss + u.pm * BM + tid, __ATOMIC_RELAXED, __HIP_MEMORY_SCOPE_AGENT);
            ls[1024 + tid] = __builtin_amdgcn_rsqf(tot * (1.f / 1024.f) + 1e-6f);
        }
        __syncthreads();
        f32x4 fw[2][2];
#pragma unroll
        for (int bj = 0; bj < 2; ++bj)
#pragma unroll
            for (int n = 0; n < 2; ++n) fw[bj][n] = *(const f32x4*)(FW + col0 + bj * HALF + n * 16);
#pragma unroll
        for (int ai = 0; ai < 2; ++ai)
#pragma unroll
            for (int m = 0; m < 4; ++m) { const size_t off = (size_t)(row0 + ai * HALF + m * 16) * 1024 + col0;
                const float rs = ls[1024 + ai * HALF + wr * 64 + m * 16 + fr];
#pragma unroll
                for (int bj = 0; bj < 2; ++bj)
#pragma unroll
                    for (int n = 0; n < 2; ++n) __builtin_nontemporal_store(acc[ai][bj][m][n] * rs * fw[bj][n], (f32x4*)(C + off + bj * HALF + n * 16)); }
        __syncthreads();
    }
};

template <class Epi, class Sched, bool STAMP = false>
__device__ __forceinline__ void gemm_phase(PG8_LAS unsigned char* lds, const Gemm g, const Sched& S, const Epi& E, unsigned long long* stamps) {
    const int tid = threadIdx.x, wid = __builtin_amdgcn_readfirstlane(tid >> 6), lane = tid & 63, wr = wid >> 2, wc = wid & 3, fr = lane & 15, fq = lane >> 4;
    const int K = g.K, nt = K / BK;
    int ts_lo = 0, ts_hi = 0, nts = 0; const unsigned long long rt_entry = STAMP ? (unsigned long long)wall_clock64() : 0ull;
#define PG8_STAMP() do { if (STAMP && wid == 0 && nts < 64) { const unsigned long long _c = (unsigned long long)clock64(); \
        ts_lo = (lane == nts) ? (int)(unsigned)_c : ts_lo; ts_hi = (lane == nts) ? (int)(unsigned)(_c >> 32) : ts_hi; ++nts; } } while (0)
    PG8_STAMP();
    unsigned voffA[2], voffB[2];
#pragma unroll
    for (int i = 0; i < 2; ++i) { int R, C; stage_rc(tid * 16 + i * 8192, R, C); const int Rb = Epi::PERM ? ((R & ~31) + perm32(R & 31)) : R;
        voffA[i] = (unsigned)(R * K + C) * 2u; voffB[i] = (unsigned)(Rb * K + C) * 2u; }
    const size_t kstep = (size_t)(BK * 2);
    const size_t hstep = (size_t)HALF * K * 2;
    const size_t tstep = 2 * hstep;
    const unsigned ldsw = (unsigned)wid * 1024u;
    const int aoff = lds_byte(wr * 64 + fr, fq * 8), boff = lds_byte(wc * 32 + fr, fq * 8);
#define PG8_SA(b, h) (((b) * 2 + (h)) * HTB)
#define PG8_SB(b, h) ((4 + (b) * 2 + (h)) * HTB)
#define PG8_STAGE(bufoff, gbase, voff) do { _Pragma("unroll") for (int _i = 0; _i < 2; ++_i) \
        __builtin_amdgcn_global_load_lds((const unsigned*)((const char*)(gbase) + (voff)[_i]), (PG8_LAS unsigned*)(lds + (bufoff) + ldsw + _i * 8192), 16, 0, 0); } while (0)
#define PG8_LDA(dst, b, h) do { _Pragma("unroll") for (int m = 0; m < 4; ++m) _Pragma("unroll") for (int k = 0; k < 2; ++k) dst[m][k] = *(const PG8_LAS bf16x8*)(lds + PG8_SA(b, h) + aoff + m * 2048 + k * 1024); } while (0)
#define PG8_LDB(dst, b, h) do { _Pragma("unroll") for (int n = 0; n < 2; ++n) _Pragma("unroll") for (int k = 0; k < 2; ++k) dst[n][k] = *(const PG8_LAS bf16x8*)(lds + PG8_SB(b, h) + boff + n * 2048 + k * 1024); } while (0)
#define PG8_MMA(ai, bj, At, Bt) do { __builtin_amdgcn_s_setprio(1); _Pragma("unroll") for (int m = 0; m < 4; ++m) _Pragma("unroll") for (int n = 0; n < 2; ++n) _Pragma("unroll") for (int k = 0; k < 2; ++k) \
        acc[ai][bj][m][n] = __builtin_amdgcn_mfma_f32_16x16x32_bf16(Bt[n][k], At[m][k], acc[ai][bj][m][n], 0, 0, 0); __builtin_amdgcn_s_setprio(0); } while (0)
#define PG8_WAIT_V(n) asm volatile("s_waitcnt vmcnt(" #n ")" ::: "memory")
#define PG8_WAIT_L(n) asm volatile("s_waitcnt lgkmcnt(" #n ")" ::: "memory")
#define PG8_BAR __builtin_amdgcn_s_barrier()
#define PG8_SCHED __builtin_amdgcn_sched_barrier(0)
    Unit cur, nxt; int ui = 0;
    if (!S.next(0, cur)) return;
    f32x4 acc[2][2][4][2];
#pragma unroll
    for (int a = 0; a < 2; ++a)
#pragma unroll
        for (int b = 0; b < 2; ++b)
#pragma unroll
            for (int m = 0; m < 4; ++m)
#pragma unroll
                for (int n = 0; n < 2; ++n) acc[a][b][m][n] = (f32x4){0.f, 0.f, 0.f, 0.f};
    bf16x8 At[4][2], B0[2][2], B1[2][2];
    const char* cA = (const char*)g.A + (size_t)cur.pm * tstep; const char* cB = (const char*)g.Bt + (size_t)cur.pn * tstep;
    S.a_ready(cur);
    PG8_STAGE(PG8_SB(0, 0), cB, voffB); PG8_STAGE(PG8_SA(0, 0), cA, voffA); PG8_STAGE(PG8_SB(0, 1), cB + hstep, voffB); PG8_STAGE(PG8_SA(0, 1), cA + hstep, voffA);
    if (wr == 1) PG8_BAR;
    PG8_WAIT_V(4); PG8_BAR;
    PG8_STAGE(PG8_SB(1, 0), cB + kstep, voffB); PG8_STAGE(PG8_SA(1, 0), cA + kstep, voffA); PG8_STAGE(PG8_SB(1, 1), cB + hstep + kstep, voffB);
    PG8_WAIT_V(6); PG8_BAR;
    PG8_STAMP();
    for (;;) {
        const bool has_next = S.next(ui + 1, nxt);
        const char* nA = has_next ? (const char*)g.A + (size_t)nxt.pm * tstep : cA; const char* nB = has_next ? (const char*)g.Bt + (size_t)nxt.pn * tstep : cB;
        for (int t = 0; t < nt; t += 2) {
            const bool last = (t == nt - 2);
            const char* a1 = cA + (size_t)(t + 1) * kstep;
            const char* a2 = last ? nA : cA + (size_t)(t + 2) * kstep; const char* b2 = last ? nB : cB + (size_t)(t + 2) * kstep;
            const char* a3 = a2 + kstep; const char* b3 = b2 + kstep;
            if (last && has_next) S.a_ready(nxt);
            PG8_LDB(B0, 0, 0); PG8_SCHED; PG8_LDA(At, 0, 0); PG8_STAGE(PG8_SA(1, 1), a1 + hstep, voffA);
            PG8_WAIT_L(8); PG8_BAR; PG8_WAIT_L(0); PG8_MMA(0, 0, At, B0); PG8_BAR; PG8_SCHED;
            PG8_LDB(B1, 0, 1); PG8_STAGE(PG8_SB(0, 0), b2, voffB);
            PG8_BAR; PG8_WAIT_L(0); PG8_MMA(0, 1, At, B1); PG8_BAR;
            PG8_LDA(At, 0, 1); PG8_STAGE(PG8_SA(0, 0), a2, voffA);
            PG8_BAR; PG8_WAIT_L(0); PG8_MMA(1, 0, At, B0); PG8_BAR; PG8_SCHED;
            PG8_STAGE(PG8_SB(0, 1), b2 + hstep, voffB);
            PG8_WAIT_V(6); PG8_BAR; PG8_MMA(1, 1, At, B1); PG8_BAR;
            PG8_LDB(B0, 1, 0); PG8_SCHED; PG8_LDA(At, 1, 0); PG8_STAGE(PG8_SA(0, 1), a2 + hstep, voffA);
            PG8_WAIT_L(8); PG8_BAR; PG8_WAIT_L(0); PG8_MMA(0, 0, At, B0); PG8_BAR; PG8_SCHED;
            PG8_LDB(B1, 1, 1); PG8_STAGE(PG8_SB(1, 0), b3, voffB);
            PG8_BAR; PG8_WAIT_L(0); PG8_MMA(0, 1, At, B1); PG8_BAR;
            PG8_LDA(At, 1, 1); PG8_STAGE(PG8_SA(1, 0), a3, voffA);
            PG8_BAR; PG8_WAIT_L(0); PG8_MMA(1, 0, At, B0); PG8_BAR; PG8_SCHED;
            PG8_STAGE(PG8_SB(1, 1), b3 + hstep, voffB);
            PG8_WAIT_V(6); PG8_BAR; PG8_MMA(1, 1, At, B1); PG8_BAR;
        }
        PG8_STAMP();
        if constexpr (!Epi::AFTER_DRAIN) { E(acc, cur, wr, wc, fr, fq); S.done(cur); }
        PG8_STAMP();
        if (!has_next) break;
#pragma unroll
        for (int a = 0; a < 2; ++a)
#pragma unroll
            for (int b = 0; b < 2; ++b)
#pragma unroll
                for (int m = 0; m < 4; ++m)
#pragma unroll
                    for (int n = 0; n < 2; ++n) acc[a][b][m][n] = (f32x4){0.f, 0.f, 0.f, 0.f};
        cur = nxt; cA = nA; cB = nB; ++ui;
    }
    PG8_WAIT_V(0);
    if (wr == 0) PG8_BAR;
    PG8_BAR;
    if constexpr (Epi::AFTER_DRAIN) { E.fused(acc, cur, wr, wc, fr, fq, lds, wid, lane); S.done(cur); }
    PG8_STAMP();
    if (STAMP && wid == 0) { stamps[lane] = lane < nts ? (((unsigned long long)(unsigned)ts_hi << 32) | (unsigned)ts_lo) : 0ull;
        if (lane == 62) stamps[62] = rt_entry; if (lane == 63) stamps[63] = (unsigned long long)wall_clock64(); }
#undef PG8_STAMP
#undef PG8_SA
#undef PG8_SB
#undef PG8_STAGE
#undef PG8_LDA
#undef PG8_LDB
#undef PG8_MMA
#undef PG8_WAIT_V
#undef PG8_WAIT_L
#undef PG8_BAR
#undef PG8_SCHED
}
}

#define GLD 72
template <int EPI>
__device__ void gemm_tile(const Params& p, const bf16_t* __restrict__ A, const bf16_t* __restrict__ Bt,
                          const int K, const int m0, const int n0, char* smem) {
  bf16_t* As = (bf16_t*)smem;
  bf16_t* Bs = As + 256 * GLD;
  const int tid = threadIdx.x, lane = tid & 63, wid = tid >> 6;
  const int r = lane & 31, hh = lane >> 5;
  const int wm = wid >> 1, wn = wid & 1;
  f32x16 acc[2][2];
#pragma unroll
  for (int i = 0; i < 2; i++)
#pragma unroll
    for (int j = 0; j < 2; j++)
#pragma unroll
      for (int e = 0; e < 16; e++) acc[i][j][e] = 0.f;
  uint4 ra0, ra1, ra2, ra3, rb0, rb1;
  const int lrow = tid >> 3, lc = (tid & 7) * 8;
  const bf16_t* Ap = A + (size_t)(m0 + lrow) * K + lc;
  const bf16_t* Bp = Bt + (size_t)(n0 + lrow) * K + lc;
#define GLOAD(kt)                                                   \
  ra0 = *(const uint4*)(Ap + (size_t)(kt) * 64);                    \
  ra1 = *(const uint4*)(Ap + (size_t)64 * K + (size_t)(kt) * 64);   \
  ra2 = *(const uint4*)(Ap + (size_t)128 * K + (size_t)(kt) * 64);  \
  ra3 = *(const uint4*)(Ap + (size_t)192 * K + (size_t)(kt) * 64);  \
  rb0 = *(const uint4*)(Bp + (size_t)(kt) * 64);                    \
  rb1 = *(const uint4*)(Bp + (size_t)64 * K + (size_t)(kt) * 64);
  const int nk = K / 64;
  GLOAD(0);
  for (int kt = 0; kt < nk; kt++) {
    __syncthreads();
    *(uint4*)(As + (lrow) * GLD + lc) = ra0;
    *(uint4*)(As + (lrow + 64) * GLD + lc) = ra1;
    *(uint4*)(As + (lrow + 128) * GLD + lc) = ra2;
    *(uint4*)(As + (lrow + 192) * GLD + lc) = ra3;
    *(uint4*)(Bs + (lrow) * GLD + lc) = rb0;
    *(uint4*)(Bs + (lrow + 64) * GLD + lc) = rb1;
    __syncthreads();
    if (kt + 1 < nk) { GLOAD(kt + 1); }
#pragma unroll
    for (int s = 0; s < 4; s++) {
      bf16x8 a[2], b[2];
#pragma unroll
      for (int i = 0; i < 2; i++) a[i] = *(const bf16x8*)(As + (wm * 64 + i * 32 + r) * GLD + s * 16 + hh * 8);
#pragma unroll
      for (int j = 0; j < 2; j++) b[j] = *(const bf16x8*)(Bs + (wn * 64 + j * 32 + r) * GLD + s * 16 + hh * 8);
#pragma unroll
      for (int i = 0; i < 2; i++)
#pragma unroll
        for (int j = 0; j < 2; j++)
          acc[i][j] = __builtin_amdgcn_mfma_f32_32x32x16_bf16(a[i], b[j], acc[i][j], 0, 0, 0);
    }
  }
  const float sc = (EPI == 0 && n0 < 512) ? QSCALE : 1.f;
#pragma unroll
  for (int i = 0; i < 2; i++)
#pragma unroll
    for (int j = 0; j < 2; j++)
#pragma unroll
      for (int e = 0; e < 16; e++) {
        const int m = m0 + wm * 64 + i * 32 + (e & 3) + 8 * (e >> 2) + 4 * hh;
        const int n = n0 + wn * 64 + j * 32 + r;
        if (EPI == 0) {
          p.proj[(size_t)m * NPROJ + n] = f2bf(acc[i][j][e] * sc);
        } else {
          p.out[(size_t)m * D_MODEL + n] = p.x[(size_t)m * D_MODEL + n] + acc[i][j][e];
        }
      }
}

#define PLD 132
#define ALD 68
typedef float f32x2 __attribute__((ext_vector_type(2)));
__device__ __forceinline__ void conv_item(const uint4 (&xr)[7], const float4 (&wlo)[4], const float4 (&whi)[4],
                                          float* dstp, const int i0, float (&ss)[4]) {
#pragma unroll
  for (int i = 0; i < 4; i++) {
    float o[8];
#pragma unroll
    for (int c = 0; c < 8; c++) o[c] = 0.f;
#pragma unroll
    for (int tap = 0; tap < 4; tap++) {
      const uint4 xv = xr[i + tap];
      const unsigned xw[4] = {xv.x, xv.y, xv.z, xv.w};
      const float wv[8] = {wlo[tap].x, wlo[tap].y, wlo[tap].z, wlo[tap].w, whi[tap].x, whi[tap].y, whi[tap].z, whi[tap].w};
#pragma unroll
      for (int c2 = 0; c2 < 4; c2++) {
        o[2 * c2] += wv[2 * c2] * __uint_as_float(xw[c2] << 16);
        o[2 * c2 + 1] += wv[2 * c2 + 1] * __uint_as_float(xw[c2] & 0xffff0000u);
      }
    }
    float sq = 0.f;
#pragma unroll
    for (int c = 0; c < 8; c++) { o[c] = silu_f(o[c]); sq += o[c] * o[c]; }
    ss[i] = sq;
    *(float4*)(dstp + (i0 + i) * PLD) = make_float4(o[0], o[1], o[2], o[3]);
    *(float4*)(dstp + (i0 + i) * PLD + 4) = make_float4(o[4], o[5], o[6], o[7]);
  }
}

__device__ void gdn_prep(const Params& p, const int task, char* smem, const int mode = 3, const int foff = 0) {
  float* qs = (float*)smem;
  float* ks = qs + 64 * PLD;
  float* vs = ks + 64 * PLD;
  float* Am = vs + 64 * PLD;
  float* gs = Am + 64 * ALD;
  float* bs = gs + 64;
  float* rq = bs + 64;
  float* rk = rq + 64;
  float* su = rk + 64;
  float* sw = su + 64;
  float* qfac = sw + 64;
  float* kfac = qfac + 64;
  int tid = threadIdx.x;
  asm volatile("" : "+v"(tid));
  const int lane = tid & 63, wid = tid >> 6;
  const int bh = task >> 5, chunk = task & 31, b = bh >> 2, hd = bh & 3;
  const int t0 = chunk * 64;
  const size_t row0 = (size_t)b * T_SEQ + t0;
  __syncthreads();
  {
    float braw = 0.f, araw = 0.f;
    if (wid == 7) { braw = p.gba[(row0 + lane) * 8 + hd]; araw = p.gba[(row0 + lane) * 8 + 4 + hd]; }
    const int itemA = tid, itemB = tid + NTHREADS;
    const int cgA = itemA % 48, segA = itemA / 48, cgB = itemB % 48, segB = itemB / 48;
    const int whA = cgA >> 4, whB = cgB >> 4;
    const int ccA = whA * 512 + hd * 128 + (cgA & 15) * 8, ccB = whB * 512 + hd * 128 + (cgB & 15) * 8;
    const bool hasB = tid < 256;
    uint4 xa[7], xb[7];
    float4 wla[4], wha[4];
    {
      const bf16_t* pa = p.proj + ((size_t)b * T_SEQ) * NPROJ + 2048 + ccA;
      const int ta = t0 + segA * 4 - 3;
#pragma unroll
      for (int j = 0; j < 7; j++) {
        const int tt = ta + j;
        const uint4 v = *(const uint4*)(pa + (size_t)(tt < 0 ? 0 : tt) * NPROJ);
        xa[j] = make_uint4(tt < 0 ? 0u : v.x, tt < 0 ? 0u : v.y, tt < 0 ? 0u : v.z, tt < 0 ? 0u : v.w);
      }
    }
    if (hasB) {
      const bf16_t* pb = p.proj + ((size_t)b * T_SEQ) * NPROJ + 2048 + ccB;
      const int tb = t0 + segB * 4 - 3;
#pragma unroll
      for (int j = 0; j < 7; j++) {
        const int tt = tb + j;
        const uint4 v = *(const uint4*)(pb + (size_t)(tt < 0 ? 0 : tt) * NPROJ);
        xb[j] = make_uint4(tt < 0 ? 0u : v.x, tt < 0 ? 0u : v.y, tt < 0 ? 0u : v.z, tt < 0 ? 0u : v.w);
      }
    }
#pragma unroll
    for (int tap = 0; tap < 4; tap++) {
      wla[tap] = *(const float4*)(p.conv_w + tap * 1536 + ccA);
      wha[tap] = *(const float4*)(p.conv_w + tap * 1536 + ccA + 4);
    }
    float ss[4];
    conv_item(xa, wla, wha, (whA == 0 ? qs : (whA == 1 ? ks : vs)) + (cgA & 15) * 8, segA * 4, ss);
    if (whA < 2) {
#pragma unroll
      for (int i = 0; i < 4; i++) {
        float v = ss[i];
        v = row16_sum(v);
        if ((lane & 15) == 0) (whA == 0 ? rq : rk)[segA * 4 + i] = v;
      }
    }
    if (hasB) {
      __builtin_amdgcn_sched_barrier(0);
#pragma unroll
      for (int tap = 0; tap < 4; tap++) {
        wla[tap] = *(const float4*)(p.conv_w + tap * 1536 + ccB);
        wha[tap] = *(const float4*)(p.conv_w + tap * 1536 + ccB + 4);
      }
      conv_item(xb, wla, wha, (whB == 0 ? qs : (whB == 1 ? ks : vs)) + (cgB & 15) * 8, segB * 4, ss);
      if (whB < 2) {
#pragma unroll
        for (int i = 0; i < 4; i++) {
          float v = ss[i];
          v = row16_sum(v);
          if ((lane & 15) == 0) (whB == 0 ? rq : rk)[segB * 4 + i] = v;
        }
      }
    }
    if (wid == 7) {
      const float beta = __builtin_amdgcn_rcpf(1.f + __expf(-braw));
      const float xx = araw + p.dt_bias[hd];
      const float sp = fmaxf(xx, 0.f) + log1pf(__expf(-fabsf(xx)));
      float g = -__expf(p.A_log[hd]) * sp;
      g += dpp_mov<0x111>(g);
      g += dpp_mov<0x112>(g);
      g += dpp_mov<0x114>(g);
      g += dpp_mov<0x118>(g);
      {
        const float t0_ = __shfl(g, 15), t1_ = __shfl(g, 31), t2_ = __shfl(g, 47);
        const int row_ = lane >> 4;
        g += (row_ > 0 ? t0_ : 0.f) + (row_ > 1 ? t1_ : 0.f) + (row_ > 2 ? t2_ : 0.f);
      }
      gs[lane] = g; bs[lane] = beta;
      if (lane == 63) st_wt_b32(p.eglast + task, __float_as_uint(__expf(g)));
    }
  }
  __syncthreads();
  if (tid < 64) {
    const float rqi = rsqrtf(rq[tid] + EPS) * 0.08838834764831845f;
    rq[tid] = rqi; qfac[tid] = rqi * __expf(gs[tid]);
  } else if (tid < 128) {
    const int i = tid - 64;
    const float rki = rsqrtf(rk[i] + EPS);
    rk[i] = rki; su[i] = bs[i]; sw[i] = bs[i] * __expf(gs[i]) * rki;
    kfac[i] = rki * __expf(gs[63] - gs[i]);
  }
  __syncthreads();
  if (mode == 1) return;
  {
    const int r = lane & 31, hh = lane >> 5;
    if (wid < 3) {
      const int ti = wid == 0 ? 0 : 1, tj = wid == 2 ? 1 : 0;
      f32x16 acc;
#pragma unroll
      for (int e = 0; e < 16; e++) acc[e] = 0.f;
#pragma unroll 4
      for (int s = 0; s < 16; s++) {
        const float4 xa = *(const float4*)(ks + (ti * 32 + r) * PLD + 8 * s + 4 * hh);
        const float4 yb = *(const float4*)(ks + (tj * 32 + r) * PLD + 8 * s + 4 * hh);
        acc = __builtin_amdgcn_mfma_f32_32x32x2f32(xa.x, yb.x, acc, 0, 0, 0);
        acc = __builtin_amdgcn_mfma_f32_32x32x2f32(xa.y, yb.y, acc, 0, 0, 0);
        acc = __builtin_amdgcn_mfma_f32_32x32x2f32(xa.z, yb.z, acc, 0, 0, 0);
        acc = __builtin_amdgcn_mfma_f32_32x32x2f32(xa.w, yb.w, acc, 0, 0, 0);
      }
      const int j = tj * 32 + r;
      const float gj = gs[j], rkj = rk[j];
#pragma unroll
      for (int e = 0; e < 16; e++) {
        const int i = ti * 32 + (e & 3) + 8 * (e >> 2) + 4 * hh;
        const float val = acc[e] * rkj * rk[i] * __expf(fminf(gs[i] - gj, 0.f));
        Am[j * ALD + i] = (j < i) ? val * bs[i] : 0.f;
      }
    } else if (wid == 3 || wid == 4) {
      const int ts0 = wid == 3 ? 0 : 2, ts1 = wid == 3 ? 2 : 3;
#pragma unroll 1
      for (int tsel = ts0; tsel < ts1; tsel++) {
        const int ti = tsel == 0 ? 0 : 1, tj = tsel == 2 ? 1 : 0;
        f32x16 acc;
#pragma unroll
        for (int e2 = 0; e2 < 16; e2++) acc[e2] = 0.f;
#pragma unroll 4
        for (int s2 = 0; s2 < 8; s2++) {
          const float* qp = qs + (ti * 32 + r) * PLD + 16 * s2 + 8 * hh;
          const float* kp = ks + (tj * 32 + r) * PLD + 16 * s2 + 8 * hh;
          const float4 q0 = *(const float4*)qp, q1 = *(const float4*)(qp + 4);
          const float4 k0 = *(const float4*)kp, k1 = *(const float4*)(kp + 4);
          union { unsigned u[4]; bf16x8 v; } fa, fb;
          fa.u[0] = cvt_pk_bf16(q0.x, q0.y); fa.u[1] = cvt_pk_bf16(q0.z, q0.w); fa.u[2] = cvt_pk_bf16(q1.x, q1.y); fa.u[3] = cvt_pk_bf16(q1.z, q1.w);
          fb.u[0] = cvt_pk_bf16(k0.x, k0.y); fb.u[1] = cvt_pk_bf16(k0.z, k0.w); fb.u[2] = cvt_pk_bf16(k1.x, k1.y); fb.u[3] = cvt_pk_bf16(k1.z, k1.w);
          acc = __builtin_amdgcn_mfma_f32_32x32x16_bf16(fa.v, fb.v, acc, 0, 0, 0);
        }
        const int j = tj * 32 + r;
        const float gj = gs[j], rkj = rk[j];
#pragma unroll
        for (int e2 = 0; e2 < 16; e2++) {
          const int i = ti * 32 + (e2 & 3) + 8 * (e2 >> 2) + 4 * hh;
          const float val = acc[e2] * rkj * rq[i] * __expf(fminf(gs[i] - gj, 0.f));
          st_wt_b16(p.AI + (size_t)task * 4096 + i * 64 + j, (unsigned)f2bf((j <= i) ? val : 0.f));
        }
      }
      if (wid == 4) {
#pragma unroll
        for (int e2 = 0; e2 < 16; e2++) {
          const int i = (e2 & 3) + 8 * (e2 >> 2) + 4 * hh;
          st_wt_b16(p.AI + (size_t)task * 4096 + i * 64 + 32 + r, 0u);
        }
      }
    } else {
      const int t2 = tid - 320;
#pragma unroll 2
      for (int v = t2; v < 1024; v += 192) {
        const int i = v >> 4, d0 = (v & 15) * 8;
        const float sc = qfac[i];
        const float4 a0 = *(const float4*)(qs + i * PLD + d0), a1 = *(const float4*)(qs + i * PLD + d0 + 4);
        st_wt_b128(p.QG + ((size_t)bh * T_SEQ + t0 + i) * 128 + d0,
                   cvt_pk_bf16(a0.x * sc, a0.y * sc), cvt_pk_bf16(a0.z * sc, a0.w * sc),
                   cvt_pk_bf16(a1.x * sc, a1.y * sc), cvt_pk_bf16(a1.z * sc, a1.w * sc));
      }
#pragma unroll 2
      for (int v = t2; v < 1024; v += 192) {
        const int d = v & 127, i0 = (v >> 7) * 8;
        float kv[8], kf[8];
#pragma unroll
        for (int e2 = 0; e2 < 8; e2++) { kv[e2] = ks[(i0 + e2) * PLD + d]; kf[e2] = kfac[i0 + e2]; }
#pragma unroll
        for (int e2 = 0; e2 < 8; e2++) kv[e2] *= kf[e2];
        st_wt_b128(p.KDt + (size_t)task * 8192 + d * 64 + i0,
                   cvt_pk_bf16(kv[0], kv[1]), cvt_pk_bf16(kv[2], kv[3]), cvt_pk_bf16(kv[4], kv[5]), cvt_pk_bf16(kv[6], kv[7]));
      }
    }
  }
  __syncthreads();
  if (mode == 2) return;
  {
    const int c = tid & 255;
    float* colp = c < 128 ? (vs + c) : (ks + (c - 128));
    const float* scl = c < 128 ? su : sw;
    bf16_t* dstW = p.W + ((size_t)bh * T_SEQ + t0) * 128 + (c & 127);
    bf16_t* dstU = p.U + (size_t)task * 8192 + (size_t)(c & 127) * 64;
#pragma unroll 1
    for (int half = 0; half < 2; half++) {
      if (tid < 256) {
#pragma unroll 1
        for (int blk = 0; blk < 2; blk++) {
          const int rb = half * 32 + blk * 16;
          float* cp = colp + rb * PLD;
          f32x2 acc[8];
          {
            float rv[16], sv[16];
#pragma unroll
            for (int ii = 0; ii < 16; ii++) { rv[ii] = cp[ii * PLD]; sv[ii] = scl[rb + ii]; }
#pragma unroll
            for (int ii = 0; ii < 16; ii++) acc[ii >> 1][ii & 1] = half == 0 ? rv[ii] * sv[ii] : rv[ii];
          }
          if (blk == 1) {
#pragma unroll 1
            for (int j0 = 0; j0 < 16; j0 += 4) {
              float xj[4];
              f32x2 av[4][8];
#pragma unroll
              for (int jj = 0; jj < 4; jj++) {
                xj[jj] = colp[(half * 32 + j0 + jj) * PLD];
                const f32x2* ap = (const f32x2*)(Am + (half * 32 + j0 + jj) * ALD + rb);
#pragma unroll
                for (int k2 = 0; k2 < 8; k2++) av[jj][k2] = ap[k2];
              }
              __builtin_amdgcn_sched_barrier(0);
#pragma unroll
              for (int jj = 0; jj < 4; jj++) {
                const f32x2 x2 = {xj[jj], xj[jj]};
#pragma unroll
                for (int k2 = 0; k2 < 8; k2++) acc[k2] -= av[jj][k2] * x2;
              }
            }
          }
          {
            float as1[8];
            f32x2 ap2[15][8];
#pragma unroll
            for (int jj = 0; jj < 15; jj++) {
              const float* arow = Am + (rb + jj) * ALD + rb;
              if ((jj & 1) == 0) as1[jj >> 1] = arow[jj + 1];
#pragma unroll
              for (int k2 = (jj >> 1) + 1; k2 < 8; k2++) ap2[jj][k2] = *(const f32x2*)(arow + 2 * k2);
            }
            __builtin_amdgcn_sched_barrier(0);
#pragma unroll
            for (int jj = 0; jj < 15; jj++) {
              const float xj = acc[jj >> 1][jj & 1];
              if ((jj & 1) == 0) acc[jj >> 1][1] -= as1[jj >> 1] * xj;
              const f32x2 x2 = {xj, xj};
#pragma unroll
              for (int k2 = (jj >> 1) + 1; k2 < 8; k2++) acc[k2] -= ap2[jj][k2] * x2;
            }
          }
#pragma unroll
          for (int ii = 0; ii < 16; ii++) cp[ii * PLD] = acc[ii >> 1][ii & 1];
          if (c < 128) {
            st_wt_b128(dstU + rb, cvt_pk_bf16(acc[0][0], acc[0][1]), cvt_pk_bf16(acc[1][0], acc[1][1]),
                       cvt_pk_bf16(acc[2][0], acc[2][1]), cvt_pk_bf16(acc[3][0], acc[3][1]));
            st_wt_b128(dstU + rb + 8, cvt_pk_bf16(acc[4][0], acc[4][1]), cvt_pk_bf16(acc[5][0], acc[5][1]),
                       cvt_pk_bf16(acc[6][0], acc[6][1]), cvt_pk_bf16(acc[7][0], acc[7][1]));
          } else {
#pragma unroll
            for (int ii = 0; ii < 16; ii++) st_wt_b16(dstW + (size_t)(rb + ii) * 128, (unsigned)f2bf(acc[ii >> 1][ii & 1]));
          }
        }
      }
      if (half == 0) {
        __syncthreads();
        const int r = lane & 31, hh = lane >> 5;
        float* arr = (wid < 4 ? vs : ks) + (wid & 3) * 32 + r;
        const float* sc2 = wid < 4 ? su : sw;
        f32x16 cacc;
#pragma unroll
        for (int e = 0; e < 16; e++) {
          const int i = 32 + (e & 3) + 8 * (e >> 2) + 4 * hh;
          cacc[e] = arr[i * PLD] * sc2[i];
        }
        {
          float av[16], bv[16];
#pragma unroll
          for (int k0 = 0; k0 < 16; k0++) { av[k0] = -Am[(2 * k0 + hh) * ALD + 32 + r]; bv[k0] = arr[(2 * k0 + hh) * PLD]; }
          __builtin_amdgcn_sched_barrier(0);
#pragma unroll
          for (int k0 = 0; k0 < 16; k0++) cacc = __builtin_amdgcn_mfma_f32_32x32x2f32(av[k0], bv[k0], cacc, 0, 0, 0);
        }
#pragma unroll
        for (int e = 0; e < 16; e++) {
          const int i = 32 + (e & 3) + 8 * (e >> 2) + 4 * hh;
          arr[i * PLD] = cacc[e];
        }
        __syncthreads();
      }
    }
  }
  asm volatile("s_waitcnt vmcnt(0)" ::: "memory");
  __syncthreads();
  if (tid == 0) __hip_atomic_store(&p.flags[foff + task], 1u, __ATOMIC_RELAXED, __HIP_MEMORY_SCOPE_AGENT);
}

#define SLD 136
#define VLD 72
__device__ void gdn_scan(const Params& p, const int bh, char* smem, const int mode = 0, const int foff = 0) {
  bf16_t* St = (bf16_t*)smem;
  bf16_t* vT = St + 128 * SLD;
  bf16_t* wsm = vT + 128 * VLD;
  bf16_t* qgs = wsm + 64 * SLD;
  bf16_t* kdTs = qgs + 64 * SLD;
  bf16_t* AIs = kdTs + 128 * VLD;
  float* obuf = (float*)wsm;
  float* nws = (float*)(smem + 120 * 1024);
  int tid = threadIdx.x;
  asm volatile("" : "+v"(tid));
  const int lane = tid & 63, wid = tid >> 6;
  const int r = lane & 31, hh = lane >> 5;
  const int mi = wid & 1, ni = wid >> 1;
  const int b = bh >> 2, hd = bh & 3;
  f32x16 accS[2];
#pragma unroll
  for (int q = 0; q < 2; q++)
#pragma unroll
    for (int e = 0; e < 16; e++) accS[q][e] = 0.f;
  __syncthreads();
  for (int idx = tid; idx < 128 * SLD / 2; idx += NTHREADS) ((unsigned*)St)[idx] = 0u;
  const int srow = tid >> 4, sc16 = (tid & 15) * 8;
  const int krow = tid >> 3, kc8 = (tid & 7) * 8;
  const int ntok = wid * 8 + (lane >> 4), nd0 = (lane & 15) * 8;
  uint4 pw0A, pw1A, pq0A, pq1A, pw0B, pw1B, pq0B, pq1B, pk0, pk1, pa0;
  uint2 un0A, un1A, un2A, un3A, un0B, un1B, un2B, un3B;
  float egnA, egnB;
#define SCAN_LOAD(nn, S)                                                                      \
  {                                                                                           \
    const int task_ = bh * 32 + (nn);                                                         \
    const size_t trow_ = (size_t)bh * T_SEQ + (nn) * 64;                                      \
    pw0##S = *(const uint4*)(p.W + (trow_ + srow) * 128 + sc16);                              \
    pw1##S = *(const uint4*)(p.W + (trow_ + srow + 32) * 128 + sc16);                         \
    pq0##S = *(const uint4*)(p.QG + (trow_ + srow) * 128 + sc16);                             \
    pq1##S = *(const uint4*)(p.QG + (trow_ + srow + 32) * 128 + sc16);                        \
    egn##S = p.eglast[task_];                                                                 \
  }
#define SCAN_LOAD_U(nn, S)                                                                    \
  {                                                                                           \
    const bf16_t* up_ = p.U + (size_t)(bh * 32 + (nn)) * 8192 + (ni * 32 + r) * 64 + mi * 32 + 4 * hh; \
    un0##S = *(const uint2*)(up_); un1##S = *(const uint2*)(up_ + 8);                         \
    un2##S = *(const uint2*)(up_ + 16); un3##S = *(const uint2*)(up_ + 24);                   \
  }
#define SCAN_LOAD_K(nn)                                                                        \
  {                                                                                           \
    const int task_ = bh * 32 + (nn);                                                         \
    pk0 = *(const uint4*)(p.KDt + (size_t)task_ * 8192 + krow * 64 + kc8);                    \
    pk1 = *(const uint4*)(p.KDt + (size_t)task_ * 8192 + (krow + 64) * 64 + kc8);             \
    pa0 = *(const uint4*)(p.AI + (size_t)task_ * 4096 + krow * 64 + kc8);                     \
  }
#define SCAN_POLL(ff, tk)                                                                          \
  while ((ff) == 0u) {                                                                             \
    __builtin_amdgcn_s_sleep(2);                                                                   \
    (ff) = __hip_atomic_load(&p.flags[foff + (tk)], __ATOMIC_RELAXED, __HIP_MEMORY_SCOPE_AGENT);  \
  }
#define SCAN_STEP(n, S) \
  { \
    const bool pollstep = tid == 0 && mode == 0 && (n & 3) == 0 && n + 3 < 32; \
    __syncthreads(); \
    *(uint4*)(wsm + srow * SLD + sc16) = pw0##S; \
    *(uint4*)(wsm + (srow + 32) * SLD + sc16) = pw1##S; \
    *(uint4*)(qgs + srow * SLD + sc16) = pq0##S; \
    *(uint4*)(qgs + (srow + 32) * SLD + sc16) = pq1##S; \
    *(uint4*)(kdTs + krow * VLD + kc8) = pk0; \
    *(uint4*)(kdTs + (krow + 64) * VLD + kc8) = pk1; \
    *(uint4*)(AIs + krow * VLD + kc8) = pa0; \
    const float eg = egn##S; \
    __syncthreads(); \
    const size_t grow0 = (size_t)b * T_SEQ + n * 64; \
    __builtin_amdgcn_sched_barrier(0); \
    if (n + 1 < 32 && mode != 1) SCAN_LOAD_K(n + 1); if (n + 2 < 32 && mode != 1) SCAN_LOAD(n + 2, S); \
    __builtin_amdgcn_sched_barrier(0); \
    f32x16 accv, acco; \
    _Pragma("unroll") \
    for (int e = 0; e < 16; e++) { accv[e] = 0.f; acco[e] = 0.f; } \
    _Pragma("unroll") \
    for (int s = 0; s < 8; s++) { \
      const bf16x8 bS = *(const bf16x8*)(St + (ni * 32 + r) * SLD + s * 16 + hh * 8); \
      const bf16x8 aW = *(const bf16x8*)(wsm + (mi * 32 + r) * SLD + s * 16 + hh * 8); \
      const bf16x8 aQ = *(const bf16x8*)(qgs + (mi * 32 + r) * SLD + s * 16 + hh * 8); \
      accv = __builtin_amdgcn_mfma_f32_32x32x16_bf16(aW, bS, accv, 0, 0, 0); \
      acco = __builtin_amdgcn_mfma_f32_32x32x16_bf16(aQ, bS, acco, 0, 0, 0); \
    } \
    _Pragma("unroll") \
    for (int g = 0; g < 4; g++) { \
      const uint2 uu_ = g == 0 ? un0##S : (g == 1 ? un1##S : (g == 2 ? un2##S : un3##S)); \
      const float v0_ = __uint_as_float(uu_.x << 16) - accv[4 * g], v1_ = __uint_as_float(uu_.x & 0xffff0000u) - accv[4 * g + 1]; \
      const float v2_ = __uint_as_float(uu_.y << 16) - accv[4 * g + 2], v3_ = __uint_as_float(uu_.y & 0xffff0000u) - accv[4 * g + 3]; \
      *(uint2*)(vT + (ni * 32 + r) * VLD + mi * 32 + 8 * g + 4 * hh) = make_uint2(cvt_pk_bf16(v0_, v1_), cvt_pk_bf16(v2_, v3_)); \
    } \
    if (n + 2 < 32 && mode != 1) SCAN_LOAD_U(n + 2, S); \
    __syncthreads(); \
    _Pragma("unroll") \
    for (int q = 0; q < 2; q++) \
    _Pragma("unroll") \
      for (int e = 0; e < 16; e++) accS[q][e] *= eg; \
    _Pragma("unroll") \
    for (int s = 0; s < 4; s++) { \
      const bf16x8 bV = *(const bf16x8*)(vT + (ni * 32 + r) * VLD + s * 16 + hh * 8); \
      const bf16x8 aA = *(const bf16x8*)(AIs + (mi * 32 + r) * VLD + s * 16 + hh * 8); \
      const bf16x8 aK0 = *(const bf16x8*)(kdTs + ((2 * mi) * 32 + r) * VLD + s * 16 + hh * 8); \
      const bf16x8 aK1 = *(const bf16x8*)(kdTs + ((2 * mi + 1) * 32 + r) * VLD + s * 16 + hh * 8); \
      accS[0] = __builtin_amdgcn_mfma_f32_32x32x16_bf16(aK0, bV, accS[0], 0, 0, 0); \
      accS[1] = __builtin_amdgcn_mfma_f32_32x32x16_bf16(aK1, bV, accS[1], 0, 0, 0); \
      acco = __builtin_amdgcn_mfma_f32_32x32x16_bf16(aA, bV, acco, 0, 0, 0); \
    } \
    _Pragma("unroll") \
    for (int q = 0; q < 2; q++) { \
      const int dkb = 2 * mi + q; \
    _Pragma("unroll") \
      for (int g = 0; g < 4; g++) \
        *(uint2*)(St + (ni * 32 + r) * SLD + dkb * 32 + 8 * g + 4 * hh) = \
            make_uint2(cvt_pk_bf16(accS[q][4 * g], accS[q][4 * g + 1]), cvt_pk_bf16(accS[q][4 * g + 2], accS[q][4 * g + 3])); \
    } \
    { \
      bf16_t* ob = (mode ? p.W : p.U) + (size_t)(bh * 32 + n) * 8192 + ni * 32 + r; \
    _Pragma("unroll") \
      for (int e = 0; e < 16; e++) { \
        const int tok = mi * 32 + (e & 3) + 8 * (e >> 2) + 4 * hh; \
        ob[tok * 128] = f2bf(acco[e]); \
      } \
    } \
    if (pollstep) { \
      _Pragma("unroll") for (int c_ = 3; c_ < 7; c_++) { \
        if (n + c_ < 32) { unsigned f_ = 0u; SCAN_POLL(f_, bh * 32 + n + c_); } \
      } \
      __builtin_amdgcn_fence(__ATOMIC_ACQUIRE, "agent"); \
      asm volatile("s_waitcnt vmcnt(0)" ::: "memory"); \
    } \
  }
  if (mode == 0) {
    if (tid == 0) {
      unsigned f0 = 0u, f1 = 0u, f2 = 0u;
      SCAN_POLL(f0, bh * 32);
      SCAN_POLL(f1, bh * 32 + 1);
      SCAN_POLL(f2, bh * 32 + 2);
      __builtin_amdgcn_fence(__ATOMIC_ACQUIRE, "agent");
      asm volatile("s_waitcnt vmcnt(0)" ::: "memory");
    }
    __syncthreads();
  }
  SCAN_LOAD(0, A);
  SCAN_LOAD_U(0, A);
  SCAN_LOAD_K(0);
  SCAN_LOAD(1, B);
  SCAN_LOAD_U(1, B);
#pragma unroll 1
  for (int n2 = 0; n2 < 32; n2 += 2) {
    { const int n = n2; SCAN_STEP(n, A) }
    { const int n = n2 + 1; SCAN_STEP(n, B) }
  }
#undef SCAN_POLL
#undef SCAN_STEP
#undef SCAN_LOAD_U
#undef SCAN_LOAD_K
#undef SCAN_LOAD
}

__device__ void gdn_normgate(const Params& p, const int task) {
  const int tid = threadIdx.x;
  const int bh = task >> 5, chunk = task & 31, b = bh >> 2, hd = bh & 3;
  const int d0 = (tid & 15) * 8;
  const size_t grow0 = (size_t)b * T_SEQ + chunk * 64;
  const float4 nw0 = *(const float4*)(p.gdn_norm_w + d0), nw1 = *(const float4*)(p.gdn_norm_w + d0 + 4);
  const float nwv[8] = {nw0.x, nw0.y, nw0.z, nw0.w, nw1.x, nw1.y, nw1.z, nw1.w};
  uint4 ov[2], gz[2];
#pragma unroll
  for (int ps = 0; ps < 2; ps++) {
    const int tok = (tid >> 4) + 32 * ps;
    ov[ps] = *(const uint4*)(p.U + (size_t)task * 8192 + tok * 128 + d0);
    gz[ps] = *(const uint4*)(p.proj + (grow0 + tok) * NPROJ + 3584 + hd * 128 + d0);
  }
#pragma unroll
  for (int ps = 0; ps < 2; ps++) {
    const int tok = (tid >> 4) + 32 * ps;
    const unsigned ow_[4] = {ov[ps].x, ov[ps].y, ov[ps].z, ov[ps].w};
    const unsigned gw[4] = {gz[ps].x, gz[ps].y, gz[ps].z, gz[ps].w};
    float o[8];
#pragma unroll
    for (int c2 = 0; c2 < 4; c2++) { o[2 * c2] = __uint_as_float(ow_[c2] << 16); o[2 * c2 + 1] = __uint_as_float(ow_[c2] & 0xffff0000u); }
    float ss = 0.f;
#pragma unroll
    for (int c = 0; c < 8; c++) ss += o[c] * o[c];
    ss = row16_sum(ss);
    const float rstd = rsqrtf(ss * (1.f / 128.f) + EPS);
    unsigned out[4];
#pragma unroll
    for (int c2 = 0; c2 < 4; c2++) {
      const float z0 = __uint_as_float(gw[c2] << 16), z1 = __uint_as_float(gw[c2] & 0xffff0000u);
      out[c2] = cvt_pk_bf16(o[2 * c2] * rstd * nwv[2 * c2] * silu_f(z0), o[2 * c2 + 1] * rstd * nwv[2 * c2 + 1] * silu_f(z1));
    }
    *(uint4*)(p.mixed + (grow0 + tok) * D_MODEL + 512 + hd * 128 + d0) = make_uint4(out[0], out[1], out[2], out[3]);
  }
}

#define KLD 72
__device__ void attn_tile(const Params& p, const int bh, const int qb, char* smem) {
  bf16_t* Ks = (bf16_t*)smem;
  bf16_t* Vt = Ks + 64 * KLD;
  int tid = threadIdx.x;
  asm volatile("" : "+v"(tid));
  const int lane = tid & 63, wid = tid >> 6;
  const int r = lane & 31, hh = lane >> 5;
  const int b = bh >> 3, hd = bh & 7;
  const int q0 = qb * 256;
  const int tq = q0 + wid * 32 + r;
  const size_t qrow = (size_t)b * T_SEQ + tq;
  bf16x8 bQ[4];
#pragma unroll
  for (int s = 0; s < 4; s++) bQ[s] = *(const bf16x8*)(p.proj + qrow * NPROJ + hd * 64 + s * 16 + hh * 8);
  f32x16 O[2];
#pragma unroll
  for (int i = 0; i < 2; i++)
#pragma unroll
    for (int e = 0; e < 16; e++) O[i][e] = 0.f;
  float R = 1.f;
  const int tmin = q0 + wid * 32;
  const int lkey = tid >> 3, lc = (tid & 7) * 8;
  const bf16_t* kvbase = p.proj + ((size_t)b * T_SEQ + lkey) * NPROJ + hd * 64 + lc;
  const int vkey = tid & 63, vd0 = (tid >> 6) * 8;
  const bf16_t* vbase = p.proj + ((size_t)b * T_SEQ + vkey) * NPROJ + 1024 + hd * 64 + vd0;
  uint4 kv, vv, kv1, vv1;
  {
    const size_t off = (size_t)(qb * 4 + 3) * 64 * NPROJ;
    kv = *(const uint4*)(kvbase + off + 512);
    vv = *(const uint4*)(vbase + off);
    kv1 = *(const uint4*)(kvbase + off - (size_t)64 * NPROJ + 512);
    vv1 = *(const uint4*)(vbase + off - (size_t)64 * NPROJ);
  }
  for (int kt = qb * 4 + 3; kt >= 0; kt--) {
    const int k0 = kt * 64;
    {
      volatile int* fl = (volatile int*)(smem + 128 * 1024 + 16);
      const bool wany = __ballot(R > ATTN_DEAD) != 0ull;
      if (lane == 0) fl[wid] = wany ? 1 : 0;
      __syncthreads();
      const int any = fl[0] | fl[1] | fl[2] | fl[3] | fl[4] | fl[5] | fl[6] | fl[7];
      if (!any) break;
    }
    {
      *(uint4*)(Ks + lkey * KLD + lc) = kv;
      const unsigned vw[4] = {vv.x, vv.y, vv.z, vv.w};
#pragma unroll
      for (int e = 0; e < 4; e++) {
        Vt[(vd0 + 2 * e) * KLD + vkey] = (bf16_t)(vw[e] & 0xffffu);
        Vt[(vd0 + 2 * e + 1) * KLD + vkey] = (bf16_t)(vw[e] >> 16);
      }
    }
    __syncthreads();
    kv = kv1; vv = vv1;
    if (kt > 1) {
      const size_t off = (size_t)(kt - 2) * 64 * NPROJ;
      kv1 = *(const uint4*)(kvbase + off + 512);
      vv1 = *(const uint4*)(vbase + off);
    }
    if (k0 > tmin + 30) continue;
    if (__ballot(R > ATTN_DEAD) == 0ull) continue;
#pragma unroll
    for (int kb = 1; kb >= 0; kb--) {
      if (k0 + kb * 32 > tmin + 30) continue;
      const bool diag = (k0 + kb * 32 + 31 >= tmin);
      bf16x8 aKf[4];
      bf16x4 vlo[2][2], vhi[2][2];
#pragma unroll
      for (int s = 0; s < 4; s++) aKf[s] = *(const bf16x8*)(Ks + (kb * 32 + r) * KLD + s * 16 + hh * 8);
#pragma unroll
      for (int s = 0; s < 2; s++)
#pragma unroll
        for (int m2 = 0; m2 < 2; m2++) {
          const bf16_t* vp = Vt + (m2 * 32 + r) * KLD + kb * 32 + 16 * s + 4 * hh;
          vlo[s][m2] = *(const bf16x4*)vp;
          vhi[s][m2] = *(const bf16x4*)(vp + 8);
        }
      __builtin_amdgcn_sched_barrier(0);
      f32x16 z;
#pragma unroll
      for (int e = 0; e < 16; e++) z[e] = 0.f;
#pragma unroll
      for (int s = 0; s < 4; s++) z = __builtin_amdgcn_mfma_f32_32x32x16_bf16(aKf[s], bQ[s], z, 0, 0, 0);
      float ev[16], fv[16];
#pragma unroll
      for (int e = 0; e < 16; e++) {
        float ex = __builtin_amdgcn_exp2f(fminf(z[e], 100.f));
        if (diag) {
          const int key = k0 + kb * 32 + (e & 3) + 8 * (e >> 2) + 4 * hh;
          if (key >= tq) ex = 0.f;
        }
        ev[e] = ex;
        fv[e] = __builtin_amdgcn_rcpf(1.f + ex);
      }
      float pv[16];
#pragma unroll
      for (int g = 3; g >= 0; g--) {
        const float s3 = fv[4 * g + 3];
        const float s2 = fv[4 * g + 2] * s3;
        const float s1 = fv[4 * g + 1] * s2;
        const float s0 = fv[4 * g] * s1;
        const float Lp = xchg32(s0, hh);
        const float c = hh ? R : R * Lp;
        pv[4 * g + 3] = ev[4 * g + 3] * s3 * c;
        pv[4 * g + 2] = ev[4 * g + 2] * s2 * c;
        pv[4 * g + 1] = ev[4 * g + 1] * s1 * c;
        pv[4 * g] = ev[4 * g] * s0 * c;
        R = R * s0 * Lp;
      }
#pragma unroll
      for (int s = 0; s < 2; s++) {
        union { unsigned u[4]; bf16x8 v; } pfu;
#pragma unroll
        for (int j = 0; j < 4; j++) pfu.u[j] = cvt_pk_bf16(pv[8 * s + 2 * j], pv[8 * s + 2 * j + 1]);
        const bf16x8 pf = pfu.v;
#pragma unroll
        for (int m2 = 0; m2 < 2; m2++) {
          const bf16x4 lo = vlo[s][m2], hi = vhi[s][m2];
          bf16x8 aV;
          aV[0] = lo[0]; aV[1] = lo[1]; aV[2] = lo[2]; aV[3] = lo[3];
          aV[4] = hi[0]; aV[5] = hi[1]; aV[6] = hi[2]; aV[7] = hi[3];
          O[m2] = __builtin_amdgcn_mfma_f32_32x32x16_bf16(aV, pf, O[m2], 0, 0, 0);
        }
      }
    }
  }
  float ss = 0.f;
#pragma unroll
  for (int i = 0; i < 2; i++)
#pragma unroll
    for (int e = 0; e < 16; e++) ss += O[i][e] * O[i][e];
  ss += xchg32(ss, hh);
  const float rstd = rsqrtf(ss * (1.f / 64.f) + EPS);
#pragma unroll
  for (int i = 0; i < 2; i++)
#pragma unroll
    for (int g = 0; g < 4; g++) {
      const int d0 = i * 32 + 8 * g + 4 * hh;
      const bf16x4 zz = *(const bf16x4*)(p.proj + qrow * NPROJ + 1536 + hd * 64 + d0);
      const float4 nw = *(const float4*)(p.sb_norm_w + d0);
      const float nwv[4] = {nw.x, nw.y, nw.z, nw.w};
      float ob[4];
#pragma unroll
      for (int c = 0; c < 4; c++) ob[c] = O[i][4 * g + c] * rstd * nwv[c] * silu_f(bf2f((bf16_t)zz[c]));
      *(uint2*)(p.mixed + qrow * D_MODEL + hd * 64 + d0) = make_uint2(cvt_pk_bf16(ob[0], ob[1]), cvt_pk_bf16(ob[2], ob[3]));
    }
}

__device__ void final_norm(const Params& p) {
  const int tid = threadIdx.x, lane = tid & 63, wid = tid >> 6;
  const int gw = blockIdx.x * 8 + wid, nw = gridDim.x * 8;
  for (int row = gw; row < M_TOK; row += nw) {
    float4* yr = (float4*)(p.out + (size_t)row * D_MODEL);
    float4 v[4];
    float ss = 0.f;
#pragma unroll
    for (int i = 0; i < 4; i++) {
      v[i] = yr[lane + 64 * i];
      ss += v[i].x * v[i].x + v[i].y * v[i].y + v[i].z * v[i].z + v[i].w * v[i].w;
    }
    ss = wave_sum(ss);
    const float rstd = rsqrtf(ss * (1.f / D_MODEL) + EPS);
#pragma unroll
    for (int i = 0; i < 4; i++) {
      const float4 w = ((const float4*)p.final_w)[lane + 64 * i];
      float4 o;
      o.x = v[i].x * rstd * w.x; o.y = v[i].y * rstd * w.y; o.z = v[i].z * rstd * w.z; o.w = v[i].w * rstd * w.w;
      yr[lane + 64 * i] = o;
    }
  }
}

__device__ void attn_tile2(const Params& p, const int bh, const int qb) {
  int tid = threadIdx.x;
  asm volatile("" : "+v"(tid));
  const int lane = tid & 63, wid = tid >> 6;
  const int r = lane & 31, hh = lane >> 5;
  const int b = bh >> 3, hd = bh & 7;
  const int tmin = qb * 256 + wid * 32;
  const int tq = tmin + r;
  const size_t qrow = (size_t)b * T_SEQ + tq;
  bf16x8 bQ[4];
#pragma unroll
  for (int s = 0; s < 4; s++) bQ[s] = *(const bf16x8*)(p.proj + qrow * NPROJ + hd * 64 + s * 16 + hh * 8);
  f32x16 O[2];
#pragma unroll
  for (int i = 0; i < 2; i++)
#pragma unroll
    for (int e = 0; e < 16; e++) O[i][e] = 0.f;
  float R = 1.f;
  const bf16_t* kbase = p.proj + ((size_t)b * T_SEQ + r) * NPROJ + 512 + hd * 64 + hh * 8;
  const bf16_t* vbase = p.proj + ((size_t)b * T_SEQ + r) * NPROJ + 1024 + hd * 64 + 4 * hh;
  bf16x8 aKn[4];
  uint2 vln[2][2], vhn[2][2];
#define A2_LOAD(ks_)                                                                              \
  {                                                                                               \
    const int k0_ = (ks_) * 32, tb_ = k0_ & ~63, kl_ = k0_ & 63;                                  \
    _Pragma("unroll") for (int s = 0; s < 4; s++) aKn[s] = *(const bf16x8*)(kbase + (size_t)k0_ * NPROJ + s * 16); \
    _Pragma("unroll") for (int s = 0; s < 2; s++)                                                 \
      _Pragma("unroll") for (int m2 = 0; m2 < 2; m2++) {                                          \
        const bf16_t* vp_ = vbase + (size_t)(tb_ + m2 * 32) * NPROJ + kl_ + 16 * s;               \
        vln[s][m2] = *(const uint2*)vp_; vhn[s][m2] = *(const uint2*)(vp_ + 8);                   \
      }                                                                                           \
  }
  int ks = tmin >> 5;
  A2_LOAD(ks);
  for (; ks >= 0; ks--) {
    const int k0 = ks * 32;
    bf16x8 aK[4];
    uint2 vl[2][2], vh[2][2];
#pragma unroll
    for (int s = 0; s < 4; s++) aK[s] = aKn[s];
#pragma unroll
    for (int s = 0; s < 2; s++)
#pragma unroll
      for (int m2 = 0; m2 < 2; m2++) { vl[s][m2] = vln[s][m2]; vh[s][m2] = vhn[s][m2]; }
    if (ks > 0) A2_LOAD(ks - 1);
    const bool diag = (k0 + 31 >= tmin);
    f32x16 z;
#pragma unroll
    for (int e = 0; e < 16; e++) z[e] = 0.f;
#pragma unroll
    for (int s = 0; s < 4; s++) z = __builtin_amdgcn_mfma_f32_32x32x16_bf16(aK[s], bQ[s], z, 0, 0, 0);
    float ev[16], fv[16];
#pragma unroll
    for (int e = 0; e < 16; e++) {
      float ex = __builtin_amdgcn_exp2f(fminf(z[e], 100.f));
      if (diag) {
        const int key = k0 + (e & 3) + 8 * (e >> 2) + 4 * hh;
        if (key >= tq) ex = 0.f;
      }
      ev[e] = ex;
      fv[e] = __builtin_amdgcn_rcpf(1.f + ex);
    }
    float pv[16];
#pragma unroll
    for (int g = 3; g >= 0; g--) {
      const float s3 = fv[4 * g + 3];
      const float s2 = fv[4 * g + 2] * s3;
      const float s1 = fv[4 * g + 1] * s2;
      const float s0 = fv[4 * g] * s1;
      const float Lp = xchg32(s0, hh);
      const float c = hh ? R : R * Lp;
      pv[4 * g + 3] = ev[4 * g + 3] * s3 * c;
      pv[4 * g + 2] = ev[4 * g + 2] * s2 * c;
      pv[4 * g + 1] = ev[4 * g + 1] * s1 * c;
      pv[4 * g] = ev[4 * g] * s0 * c;
      R = R * s0 * Lp;
    }
#pragma unroll
    for (int s = 0; s < 2; s++) {
      union { unsigned u[4]; bf16x8 v; } pfu;
#pragma unroll
      for (int j = 0; j < 4; j++) pfu.u[j] = cvt_pk_bf16(pv[8 * s + 2 * j], pv[8 * s + 2 * j + 1]);
#pragma unroll
      for (int m2 = 0; m2 < 2; m2++) {
        union { unsigned u[4]; bf16x8 v; } avu;
        avu.u[0] = vl[s][m2].x; avu.u[1] = vl[s][m2].y; avu.u[2] = vh[s][m2].x; avu.u[3] = vh[s][m2].y;
        O[m2] = __builtin_amdgcn_mfma_f32_32x32x16_bf16(avu.v, pfu.v, O[m2], 0, 0, 0);
      }
    }
    if (__ballot(R > ATTN_DEAD) == 0ull) break;
  }
#undef A2_LOAD
  float ss = 0.f;
#pragma unroll
  for (int i = 0; i < 2; i++)
#pragma unroll
    for (int e = 0; e < 16; e++) ss += O[i][e] * O[i][e];
  ss += xchg32(ss, hh);
  const float rstd = rsqrtf(ss * (1.f / 64.f) + EPS);
#pragma unroll
  for (int i = 0; i < 2; i++)
#pragma unroll
    for (int g = 0; g < 4; g++) {
      const int d0 = i * 32 + 8 * g + 4 * hh;
      const bf16x4 zz = *(const bf16x4*)(p.proj + qrow * NPROJ + 1536 + hd * 64 + d0);
      const float4 nw = *(const float4*)(p.sb_norm_w + d0);
      const float nwv[4] = {nw.x, nw.y, nw.z, nw.w};
      float ob[4];
#pragma unroll
      for (int c = 0; c < 4; c++) ob[c] = O[i][4 * g + c] * rstd * nwv[c] * silu_f(bf2f((bf16_t)zz[c]));
      *(uint2*)(p.mixed + qrow * D_MODEL + hd * 64 + d0) = make_uint2(cvt_pk_bf16(ob[0], ob[1]), cvt_pk_bf16(ob[2], ob[3]));
    }
}

#define SMEM_BYTES (128 * 1024 + 64)
__global__ void __launch_bounds__(NTHREADS) fwd_megakernel(Params p) {
  extern __shared__ __attribute__((aligned(16))) char smem[];
  cg::grid_group grid = cg::this_grid();
  volatile int* s_item_p = (volatile int*)(smem + 128 * 1024);
  if (p.coop_flag) grid.sync();
  if (threadIdx.x < 4) ((volatile unsigned*)(smem + 128 * 1024 + 48))[threadIdx.x] = 0u;
  __syncthreads();
  XcdBarrier xb = xcd_barrier_post(p.bar, (volatile LAS unsigned*)(smem + 128 * 1024 + 48));

#ifndef NO_P0
  phase0(p, smem);
#ifdef REP_P0
  phase0(p, smem);
#endif
#endif
  xcd_barrier(xb);
  {
    pg8::Gemm g{p.h, p.Wt, M_TOK, NPROJ, 1024};
    pg8::StaticOrder S; S.init(M_TOK, NPROJ, gridDim.x, blockIdx.x);
    pg8::EpiProj E{p.proj};
    pg8::gemm_phase<pg8::EpiProj, pg8::StaticOrder, false>((PG8_LAS unsigned char*)smem, g, S, E, nullptr);
#ifdef REP_G0
    pg8::gemm_phase<pg8::EpiProj, pg8::StaticOrder, false>((PG8_LAS unsigned char*)smem, g, S, E, nullptr);
#endif
  }
  xcd_barrier(xb);
#if defined(REP_MERGED) && REP_MERGED > 0
  for (int rep = 0; rep < 2; rep++)
#else
  const int rep = 0;
#endif
  {
#define NEXT_ITEM()                                                              \
  {                                                                              \
    __syncthreads();                                                             \
    if (threadIdx.x == 0) *s_item_p = (int)atomicAdd(&p.counters[rep], 1u);      \
    __syncthreads();                                                             \
    item = *s_item_p;                                                            \
  }
    int item;
    NEXT_ITEM();
#ifndef REP_MERGED
#define REP_MERGED 0
#define REP_MERGED_UNDEF
#endif
    while (item < SCAN_AT) {
      if (!(rep == 1 && REP_MERGED == 2)) gdn_prep(p, (item & 31) * 32 + (item >> 5), smem, 3, rep * 1024);
      NEXT_ITEM();
    }
    while (item < SCAN_AT + 32) {
      if (!(rep == 1 && REP_MERGED == 2)) gdn_scan(p, item - SCAN_AT, smem, 0, rep * 1024);
      NEXT_ITEM();
    }
    while (item < 1056) {
      const int k = item - 32;
      if (!(rep == 1 && REP_MERGED == 2)) gdn_prep(p, (k & 31) * 32 + (k >> 5), smem, 3, rep * 1024);
      NEXT_ITEM();
    }
    while (item < 1568) {
      const int j = item - 1056;
      if (!(rep == 1 && REP_MERGED == 3)) attn_tile2(p, j & 63, 7 - (j >> 6));
      NEXT_ITEM();
    }
#undef NEXT_ITEM
    xcd_barrier(xb);
  }
  for (int t = blockIdx.x; t < 1024; t += gridDim.x) gdn_normgate(p, t);
#ifdef REP_NG
  for (int r_ = 0; r_ < 4; r_++) for (int t = blockIdx.x; t < 1024; t += gridDim.x) gdn_normgate(p, t);
#endif
  xcd_barrier(xb);
  {
    pg8::Gemm g{p.mixed, p.WoT, M_TOK, D_MODEL, 1024};
    pg8::StaticOrder S; S.init(M_TOK, D_MODEL, gridDim.x, blockIdx.x);
    pg8::EpiOutNorm E{p.out, p.x, p.final_w, p.rowss, p.pcnt};
    pg8::gemm_phase<pg8::EpiOutNorm, pg8::StaticOrder, false>((PG8_LAS unsigned char*)smem, g, S, E, nullptr);
#ifdef REP_G1
    xcd_barrier(xb);
    pg8::EpiOutNorm E2{p.out, p.x, p.final_w, p.rowss + 16384 + 64, p.pcnt + 16384 + 64};
    pg8::gemm_phase<pg8::EpiOutNorm, pg8::StaticOrder, false>((PG8_LAS unsigned char*)smem, g, S, E2, nullptr);
#endif
  }

}

extern "C" void kernel_launch(void* const* d_in, const int* in_sizes, int n_in, void* d_out, int out_size,
                              void* d_ws, size_t ws_size, hipStream_t stream) {
  static int grid_blocks = 0;
  if (!grid_blocks) {
    int dev = 0, cus = 0, per_cu = 0;
    hipGetDevice(&dev);
    hipDeviceGetAttribute(&cus, hipDeviceAttributeMultiprocessorCount, dev);
    hipFuncSetAttribute((const void*)fwd_megakernel, hipFuncAttributeMaxDynamicSharedMemorySize, SMEM_BYTES);
    hipOccupancyMaxActiveBlocksPerMultiprocessor(&per_cu, fwd_megakernel, NTHREADS, SMEM_BYTES);
    if (per_cu < 1) per_cu = 1;
    grid_blocks = cus * per_cu;
  }
  Params p{};
  p.x = (const float*)d_in[0]; p.norm1_w = (const float*)d_in[1]; p.w_in = (const float*)d_in[2];
  p.sb_norm_w = (const float*)d_in[3]; p.conv_w = (const float*)d_in[4]; p.A_log = (const float*)d_in[5];
  p.dt_bias = (const float*)d_in[6]; p.gdn_norm_w = (const float*)d_in[7]; p.w_out = (const float*)d_in[8];
  p.final_w = (const float*)d_in[9];
  p.out = (float*)d_out;
  char* ws = (char*)d_ws;
  const size_t MiB = 1024 * 1024;
  p.Wt = (bf16_t*)(ws + 0 * MiB);
  p.WoT = (bf16_t*)(ws + 8 * MiB);
  p.gba = (float*)(ws + 10 * MiB);
  p.counters = (unsigned*)(ws + 10 * MiB + 512 * 1024);
  p.eglast = (float*)(ws + 10 * MiB + 512 * 1024 + 4096);
  p.h = (bf16_t*)(ws + 11 * MiB);
  p.mixed = (bf16_t*)(ws + 11 * MiB);
  p.proj = (bf16_t*)(ws + 43 * MiB);
  p.U = (bf16_t*)(ws + 171 * MiB);
  p.W = (bf16_t*)(ws + 187 * MiB);
  p.QG = (bf16_t*)(ws + 203 * MiB);
  p.KDt = (bf16_t*)(ws + 219 * MiB);
  p.AI = (bf16_t*)(ws + 235 * MiB);
  p.bar = (unsigned*)(ws + 10 * MiB + 512 * 1024 + 8192);
  p.flags = (unsigned*)(ws + 10 * MiB + 512 * 1024 + 24576);
  p.coop_flag = 0u; p.pad_ = 0u;
  p.rowss = (float*)(ws + 10 * MiB + 512 * 1024 + 32768);
  p.pcnt = (unsigned*)(ws + 10 * MiB + 512 * 1024 + 32768 + 65536);

#ifdef REP_G1
  hipMemsetAsync(p.counters, 0, 32768 + 2 * (65536 + 256), stream);
#else
  hipMemsetAsync(p.counters, 0, 32768 + 65536 + 256, stream);
#endif
  void* args[] = {&p};
  hipError_t e = hipLaunchCooperativeKernel((void*)fwd_megakernel, dim3(grid_blocks), dim3(NTHREADS), args,
                                            SMEM_BYTES, stream);
  if (e != hipSuccess) fprintf(stderr, "cooperative launch failed: %s (grid %d)\n", hipGetErrorString(e), grid_blocks);
}
```
